# Optimizing an MI355X kernel written in HIP

```python
import math
import jax
import jax.numpy as jnp
from jax import lax
import numpy as np

D_MODEL = 1024
BATCH = 16
SEQ = 256
DEPTH = 2
DEC_BATCH = 4
DEC_SEQ = 4096
PAST_LEN = 512

GRID_W = 64
EPS = 1e-6
D_A = 512
SHORT_K = 3
EMB_DIM = 33
FILT_ORDER = 64
DECAY_TARGET = 1e-2
FAST_DECAY_PCT = 0.3
SLOW_DECAY_PCT = 1.5
MIN_DECAY = math.log(DECAY_TARGET) / SLOW_DECAY_PCT
MAX_DECAY = math.log(DECAY_TARGET) / FAST_DECAY_PCT
N_HEADS_B = 8
Q_RANK = 256
KV_RANK = 256
NOPE_DIM = 64
ROPE_DIM = 32
V_DIM = 64
ROPE_BASE = 10000.0
D_B = N_HEADS_B * V_DIM
QK_DIM = NOPE_DIM + ROPE_DIM
ATTN_SCALE = 1.0 / math.sqrt(QK_DIM)
Q_BLOCK = 128
D_C = 1024
N_GROUPS_C = 8
G_C = D_C // N_GROUPS_C
N_EVEN = (DEPTH + 1) // 2
N_ODD = DEPTH // 2
IN_E = 4 * D_A + Q_RANK + KV_RANK + ROPE_DIM + D_B
SPLIT_E = [3 * D_A, 4 * D_A, 4 * D_A + Q_RANK, 4 * D_A + Q_RANK + KV_RANK, 4 * D_A + Q_RANK + KV_RANK + ROPE_DIM]

kernel_name = 'hybrid_hyena_mla_fnet_prefix_step'


def rmsnorm(x, g):
    xf = x.astype(jnp.float32)
    y = xf * lax.rsqrt(jnp.mean(xf * xf, axis=-1, keepdims=True) + EPS)
    return (y * g.astype(jnp.float32)).astype(x.dtype)


def ada_params(cond, w_mod, b_mod):
    mod = jax.nn.silu(cond) @ w_mod + b_mod
    shift, scale, gate = jnp.split(mod[:, None, :], 3, axis=-1)
    return shift, scale, gate


def short_conv(u, w, b):
    L = u.shape[1]
    pad = SHORT_K // 2
    up = jnp.pad(u, ((0, 0), (pad, pad), (0, 0)))
    return b + sum(up[:, k:k + L] * w[k] for k in range(SHORT_K))


def hyena_filters(L, w1, b1, w2, b2, w3):
    f32 = jnp.float32
    t = jnp.linspace(0.0, 1.0, L, dtype=f32)[:, None]
    w = 2.0 * math.pi * jnp.arange(L, dtype=f32)[:, None] / L
    bands = (EMB_DIM - 1) // 2
    f = jnp.linspace(1e-4, bands - 1, bands, dtype=f32)[None, :]
    z = jnp.concatenate([t, jnp.cos(f * w), -jnp.sin(f * w)], axis=-1)
    h = jnp.sin(z @ w1.astype(f32) + b1.astype(f32))
    h = jnp.sin(h @ w2.astype(f32) + b2.astype(f32))
    h = (h @ w3.astype(f32)).reshape(L, 2, D_A)
    deltas = jnp.abs(jnp.linspace(MIN_DECAY, MAX_DECAY, D_A, dtype=f32))
    h = h * jnp.exp(-t * deltas)[:, None, :]
    h = h / jnp.sum(jnp.abs(h), axis=(0, 1), keepdims=True)
    return h[:, 0], h[:, 1]


def hyena(u, conv_w, conv_b, filt, skip):
    L = u.shape[1]
    u = short_conv(u, conv_w, conv_b)
    x0, x1, v = jnp.split(u, 3, axis=-1)
    v = v * x1
    h_fwd, h_bwd = hyena_filters(L, *filt)
    kern = jnp.concatenate([h_fwd, jnp.zeros((1, D_A), jnp.float32), h_bwd[:0:-1]], axis=0)
    vf = jnp.fft.rfft(v.astype(jnp.float32), n=2 * L, axis=1)
    kf = jnp.fft.rfft(kern, n=2 * L, axis=0)
    y = jnp.fft.irfft(vf * kf[None], n=2 * L, axis=1)[:, :L]
    y = y.astype(u.dtype) + v * skip
    return y * x0


def axial_rope_tables(L):
    rows = L // GRID_W
    row = jnp.repeat(jnp.arange(rows, dtype=jnp.float32), GRID_W)
    col = jnp.tile(jnp.arange(GRID_W, dtype=jnp.float32), rows)
    half = ROPE_DIM // 2
    inv = jnp.power(ROPE_BASE, -jnp.arange(0, half, 2, dtype=jnp.float32) / half)
    ang = jnp.stack([row[:, None] * inv, col[:, None] * inv], axis=1)
    return jnp.cos(ang), jnp.sin(ang)


def apply_axial_rope(x, cos, sin):
    nf = ROPE_DIM // 4
    xr = x.astype(jnp.float32).reshape(x.shape[:-1] + (2, 2, nf))
    shp = (cos.shape[0],) + (1,) * (x.ndim - 3) + (2, nf)
    c = cos.reshape(shp)
    s = sin.reshape(shp)
    x1, x2 = xr[..., 0, :], xr[..., 1, :]
    out = jnp.stack([x1 * c - x2 * s, x1 * s + x2 * c], axis=-2)
    return out.reshape(x.shape).astype(x.dtype)


def block_attention(q, k, v):
    B, Lq, H, Dq = q.shape
    nb = Lq // Q_BLOCK
    qb = q.reshape(B, nb, Q_BLOCK, H, Dq).transpose(1, 0, 2, 3, 4)

    def one_block(qi):
        s = jnp.einsum('bqhd,bkhd->bhqk', qi, k).astype(jnp.float32) * ATTN_SCALE
        p = jax.nn.softmax(s, axis=-1)
        return jnp.einsum('bhqk,bkhd->bqhd', p.astype(v.dtype), v)

    o = lax.map(one_block, qb)
    return o.transpose(1, 0, 2, 3, 4).reshape(B, Lq, H, v.shape[-1])


def even_mixer(h, ew, ctx_kv):
    (w_in, conv_w, conv_b, f_w1, f_b1, f_w2, f_b2, f_w3, skip, qg, kvg, w_uq, w_ukv, w_out) = ew
    B, L, _ = h.shape
    proj = h @ w_in
    u_a, g_a, cq, ckv, krope, g_b = jnp.split(proj, SPLIT_E, axis=-1)
    y_a = hyena(u_a, conv_w, conv_b, (f_w1, f_b1, f_w2, f_b2, f_w3), skip)
    cq = rmsnorm(cq, qg)
    ckv = rmsnorm(ckv, kvg)
    q = (cq @ w_uq).reshape(B, L, N_HEADS_B, QK_DIM)
    if ctx_kv is None:
        keys_c, keys_r = ckv, krope
    else:
        cos, sin = axial_rope_tables(L)
        q = jnp.concatenate([q[..., :NOPE_DIM], apply_axial_rope(q[..., NOPE_DIM:], cos, sin)], axis=-1)
        ctx_ckv, ctx_krope = ctx_kv
        keys_c = jnp.concatenate([ctx_ckv, ckv], axis=1)
        keys_r = jnp.concatenate([ctx_krope, apply_axial_rope(krope, cos, sin)], axis=1)
    Lk = keys_c.shape[1]
    kv = (keys_c @ w_ukv).reshape(B, Lk, N_HEADS_B, NOPE_DIM + V_DIM)
    k = jnp.concatenate([kv[..., :NOPE_DIM], jnp.broadcast_to(keys_r[:, :, None, :], (B, Lk, N_HEADS_B, ROPE_DIM))], axis=-1)
    v = kv[..., NOPE_DIM:]
    o_b = block_attention(q, k, v).reshape(B, L, D_B)
    y = jnp.concatenate([y_a * jax.nn.silu(g_a), o_b * jax.nn.silu(g_b)], axis=-1) @ w_out
    return y, ckv, krope


def odd_mixer(h, w_in, fnet_w, w_out):
    B, L, _ = h.shape
    u, g = jnp.split(h @ w_in, 2, axis=-1)
    uf = u.astype(jnp.float32).reshape(B, L, N_GROUPS_C, G_C)
    m = jnp.fft.fft2(uf, axes=(1, 3), norm='ortho').real.astype(h.dtype)
    y = jnp.einsum('blgc,gcd->blgd', m, fnet_w).reshape(B, L, D_C)
    return (y * jax.nn.silu(g)) @ w_out


def setup_inputs(seed: int = 0) -> dict:
    key = jax.random.key(seed)
    ks = jax.random.split(key, 32)
    f32 = jnp.float32

    def nrm(k, shape, s):
        return jax.random.normal(k, shape, f32) * s

    return {
        'x_prompt': nrm(ks[0], (BATCH, SEQ, D_MODEL), 1.0),
        'x_sample': nrm(ks[1], (DEC_BATCH, DEC_SEQ, D_MODEL), 1.0),
        'c': nrm(ks[2], (DEC_BATCH, D_MODEL), 1.0),
        'cache_ckv': nrm(ks[3], (DEC_BATCH, N_EVEN, PAST_LEN, KV_RANK), 1.0),
        'cache_krope': nrm(ks[4], (DEC_BATCH, N_EVEN, PAST_LEN, ROPE_DIM), 1.0),
        'c_ctx': nrm(ks[5], (D_MODEL,), 1.0),
        'norm_g': 1.0 + nrm(ks[6], (DEPTH, D_MODEL), 0.02),
        'w_mod': nrm(ks[7], (DEPTH, D_MODEL, 3 * D_MODEL), D_MODEL ** -0.5),
        'b_mod': nrm(ks[8], (DEPTH, 3 * D_MODEL), 0.02),
        'w_in_e': nrm(ks[9], (N_EVEN, D_MODEL, IN_E), D_MODEL ** -0.5),
        'conv_w': nrm(ks[10], (N_EVEN, SHORT_K, 3 * D_A), SHORT_K ** -0.5),
        'conv_b': nrm(ks[11], (N_EVEN, 3 * D_A), 0.02),
        'filt_w1': nrm(ks[12], (N_EVEN, EMB_DIM, FILT_ORDER), EMB_DIM ** -0.5),
        'filt_b1': nrm(ks[13], (N_EVEN, FILT_ORDER), 0.02),
        'filt_w2': nrm(ks[14], (N_EVEN, FILT_ORDER, FILT_ORDER), FILT_ORDER ** -0.5),
        'filt_b2': nrm(ks[15], (N_EVEN, FILT_ORDER), 0.02),
        'filt_w3': nrm(ks[16], (N_EVEN, FILT_ORDER, 2 * D_A), FILT_ORDER ** -0.5),
        'hyena_skip': nrm(ks[17], (N_EVEN, D_A), 1.0),
        'q_norm_g': 1.0 + nrm(ks[18], (N_EVEN, Q_RANK), 0.02),
        'kv_norm_g': 1.0 + nrm(ks[19], (N_EVEN, KV_RANK), 0.02),
        'w_uq': nrm(ks[20], (N_EVEN, Q_RANK, N_HEADS_B * QK_DIM), Q_RANK ** -0.5),
        'w_ukv': nrm(ks[21], (N_EVEN, KV_RANK, N_HEADS_B * (NOPE_DIM + V_DIM)), KV_RANK ** -0.5),
        'w_out_e': nrm(ks[22], (N_EVEN, D_A + D_B, D_MODEL), (D_A + D_B) ** -0.5),
        'w_in_o': nrm(ks[23], (N_ODD, D_MODEL, 2 * D_C), D_MODEL ** -0.5),
        'fnet_w': nrm(ks[24], (N_ODD, N_GROUPS_C, G_C, G_C), G_C ** -0.5),
        'w_out_o': nrm(ks[25], (N_ODD, D_C, D_MODEL), D_C ** -0.5),
        'final_g': 1.0 + nrm(ks[26], (D_MODEL,), 0.02),
    }


def reference(x_prompt, x_sample, c, cache_ckv, cache_krope, c_ctx, norm_g, w_mod, b_mod,
              w_in_e, conv_w, conv_b, filt_w1, filt_b1, filt_w2, filt_b2, filt_w3, hyena_skip,
              q_norm_g, kv_norm_g, w_uq, w_ukv, w_out_e, w_in_o, fnet_w, w_out_o, final_g):
    xp = x_prompt
    xs = x_sample
    new_ckv = []
    new_krope = []
    for i in range(DEPTH):
        j = i // 2
        sh_p, sc_p, gt_p = ada_params(c_ctx[None, :], w_mod[i], b_mod[i])
        sh_s, sc_s, gt_s = ada_params(c, w_mod[i], b_mod[i])
        hp = rmsnorm(xp, norm_g[i]) * (1.0 + sc_p) + sh_p
        hs = rmsnorm(xs, norm_g[i]) * (1.0 + sc_s) + sh_s
        if i % 2 == 0:
            ew = (w_in_e[j], conv_w[j], conv_b[j], filt_w1[j], filt_b1[j], filt_w2[j], filt_b2[j],
                  filt_w3[j], hyena_skip[j], q_norm_g[j], kv_norm_g[j], w_uq[j], w_ukv[j], w_out_e[j])
            yp, ckv_p, krope_p = even_mixer(hp, ew, None)
            ys, _, _ = even_mixer(hs, ew, (cache_ckv[:, j], cache_krope[:, j]))
            new_ckv.append(ckv_p)
            new_krope.append(krope_p)
        else:
            yp = odd_mixer(hp, w_in_o[j], fnet_w[j], w_out_o[j])
            ys = odd_mixer(hs, w_in_o[j], fnet_w[j], w_out_o[j])
        xp = xp + gt_p * yp
        xs = xs + gt_s * ys
    y_prompt = rmsnorm(xp, final_g)
    y_sample = rmsnorm(xs, final_g)
    state_ckv = jnp.stack(new_ckv, axis=1)
    state_krope = jnp.stack(new_krope, axis=1)
    return (y_prompt, y_sample, state_ckv, state_krope)
```

```cpp
#include <hip/hip_runtime.h>
#include <cstdio>
#include <cstdint>

#ifndef MK_N_LAUNCHES
#define MK_N_LAUNCHES 0
#endif

constexpr int DM = 1024;
constexpr int NPR = 4096;
constexpr int NSM = 16384;
constexpr int NTOK = NPR + NSM;
constexpr int LPR = 256, LSM = 4096, PAST = 512, LKS = PAST + LSM;
constexpr int NKV = NPR + 4 * LKS;
constexpr int DA = 512, NH = 8, QKD = 96, NOPE = 64, ROPED = 32, VD = 64;
constexpr float EPS = 1e-6f;
constexpr float ATTN_SCALE_LOG2E = 0.10206207261596575f * 1.4426950408889634f;

constexpr size_t MiB = 1u << 20, KiB = 1u << 10;
constexpr size_t WS_CTL = 0, CTL_ZERO_BYTES = 64 * KiB;
constexpr size_t WS_MOD = 1 * MiB;
constexpr size_t WS_ROPE = 1 * MiB + 128 * KiB;
constexpr size_t WS_SSQQ = 1 * MiB + 256 * KiB;
constexpr size_t WS_SSQKV = 1 * MiB + 576 * KiB;
constexpr size_t WS_PQ = 2 * MiB;
constexpr size_t WS_PS = 3 * MiB;
constexpr size_t WS_TW = 5 * MiB;
constexpr size_t WS_WT_IN_E = 6 * MiB;
constexpr size_t WS_WT_UQ = 12 * MiB + 512 * KiB;
constexpr size_t WS_WT_UK = 12 * MiB + 896 * KiB;
constexpr size_t WS_WT_UV = 13 * MiB + 128 * KiB;
constexpr size_t WS_WT_OUT_E = 13 * MiB + 512 * KiB;
constexpr size_t WS_WT_IN_O = 15 * MiB + 512 * KiB;
constexpr size_t WS_WT_OUT_O = 21 * MiB + 512 * KiB;
constexpr size_t WS_KF0 = 24 * MiB;
constexpr size_t WS_KF1 = 32 * MiB;
constexpr size_t WS_H = 36 * MiB;
constexpr size_t WS_VT = 36 * MiB;
constexpr size_t WS_YT = 58 * MiB;
constexpr size_t WS_UT = 78 * MiB;
constexpr size_t WS_Z = 78 * MiB;
constexpr size_t WS_A = 78 * MiB, WS_B = 118 * MiB, WS_SG = 158 * MiB;
constexpr size_t WS_CQ = 158 * MiB;
constexpr size_t WS_CKV = 168 * MiB;
constexpr size_t WS_KR = 179 * MiB;
constexpr size_t WS_SGB = 181 * MiB;
constexpr size_t WS_Q = 201 * MiB;
constexpr size_t WS_KN = 231 * MiB;
constexpr size_t WS_TR = 198 * MiB, WS_TI = 36 * MiB;
constexpr size_t WS_Z2 = 70 * MiB;
constexpr size_t WS_END = 253 * MiB;

typedef unsigned short bf16;
typedef float f32x4 __attribute__((ext_vector_type(4)));
typedef float f32x16 __attribute__((ext_vector_type(16)));
typedef unsigned u32x4 __attribute__((ext_vector_type(4)));
typedef unsigned u32x2 __attribute__((ext_vector_type(2)));
typedef short bf16x8 __attribute__((ext_vector_type(8)));

__device__ __forceinline__ unsigned f2bf(float f) { unsigned u = __float_as_uint(f); return (u + 0x7fffu + ((u >> 16) & 1u)) >> 16; }
__device__ __forceinline__ float bf2f(unsigned h) { return __uint_as_float(h << 16); }
__device__ __forceinline__ unsigned pk2(float lo, float hi) { return f2bf(lo) | (f2bf(hi) << 16); }
__device__ __forceinline__ float siluf(float x) { return x * __builtin_amdgcn_rcpf(1.0f + __expf(-x)); }
__device__ __forceinline__ int kvrow_of(int r) { if (r < NPR) return r; const int s = r - NPR; return NPR + (s >> 12) * LKS + PAST + (s & 4095); }

namespace pg8 {
#define PG8_LAS __attribute__((address_space(3)))
typedef unsigned short bf16_t;
typedef short bf16x8 __attribute__((ext_vector_type(8)));
typedef float f32x4 __attribute__((ext_vector_type(4)));
typedef unsigned u32x4 __attribute__((ext_vector_type(4)));
constexpr int BM = 256, BK = 64, HALF = 128, HTB = HALF * BK * 2  , STAGE_BYTES = 8 * HTB, NXCD = 8, WGM = 8;

__host__ __device__ __forceinline__ int lds_byte(int r, int c) { const int st = (r >> 4) * 2 + (c >> 5), rr = r & 15, cc = c & 31, ob = rr * 64 + cc * 2; return st * 1024 + (ob ^ (((ob >> 9) & 1) << 5)); }
__host__ __device__ __forceinline__ void stage_rc(int b, int& R, int& C) { const int st = b / 1024, sb = b % 1024, swz = sb ^ (((sb >> 9) & 1) << 5); R = (st >> 1) * 16 + swz / 64; C = (st & 1) * 32 + (swz % 64) / 2; }
__host__ __device__ __forceinline__ int perm32(int rho) { const int n = rho >> 4, i = rho & 15; return 8 * (i >> 2) + 4 * n + (i & 3); }

struct Unit { int pm, pn; };
struct Gemm { const bf16_t* A; const bf16_t* Bt; int M, N, K; };

struct StaticOrder {
    int nM, nN, nwg, G, c;
    __host__ __device__ void init(int M, int N, int G_, int c_) { nM = M / BM; nN = N / BM; nwg = nM * nN; G = G_; c = c_; }
    __host__ __device__ bool next(int i, Unit& u) const {
        const long L = (long)i * G + c; if (L >= nwg) return false;
        int wgid = (int)L; { const int q = nwg / NXCD, r = nwg % NXCD, xcd = wgid % NXCD, off = wgid / NXCD; wgid = (xcd < r ? xcd * (q + 1) : r * (q + 1) + (xcd - r) * q) + off; }
        const int nig = WGM * nN, gid = wgid / nig, fm = gid * WGM, gsz = (nM - fm) < WGM ? (nM - fm) : WGM;
        u.pm = fm + ((wgid % nig) % gsz); u.pn = (wgid % nig) / gsz; return true;
    }
    __device__ __forceinline__ void a_ready(const Unit&) const {}
    __device__ __forceinline__ void done(const Unit&) const {}
};

typedef float f32x2_t __attribute__((ext_vector_type(2))); typedef __bf16 bf16x2_t __attribute__((ext_vector_type(2)));
__device__ __forceinline__ unsigned cvt_pk_bf16(float lo, float hi) { f32x2_t v = {lo, hi}; bf16x2_t b = __builtin_convertvector(v, bf16x2_t); return __builtin_bit_cast(unsigned, b); }
__device__ __forceinline__ u32x4 pack8(const f32x4 a, const f32x4 b) { u32x4 w; w.x = cvt_pk_bf16(a[0], a[1]); w.y = cvt_pk_bf16(a[2], a[3]); w.z = cvt_pk_bf16(b[0], b[1]); w.w = cvt_pk_bf16(b[2], b[3]); return w; }
__device__ __forceinline__ f32x4 silu4(f32x4 v) { f32x4 o; o[0] = siluf(v[0]); o[1] = siluf(v[1]); o[2] = siluf(v[2]); o[3] = siluf(v[3]); return o; }
__device__ __forceinline__ f32x4 shfl16_4(f32x4 v) { f32x4 o; o[0] = __shfl_xor(v[0], 16); o[1] = __shfl_xor(v[1], 16); o[2] = __shfl_xor(v[2], 16); o[3] = __shfl_xor(v[3], 16); return o; }
__device__ __forceinline__ void rope4(f32x4& v, int fq, const float* __restrict__ tb) {
    const f32x4 p = shfl16_4(v); const f32x4 t0 = *(const f32x4*)tb, t1 = *(const f32x4*)(tb + 4);
    const float c[4] = {t0[0], t0[2], t1[0], t1[2]}, s[4] = {t0[1], t0[3], t1[1], t1[3]};
    const float sg = (fq & 1) ? 1.0f : -1.0f;
#pragma unroll
    for (int e = 0; e < 4; ++e) v[e] = v[e] * c[e] + sg * (p[e] * s[e]);
}
__device__ __forceinline__ void rope8(f32x4& v0, f32x4& v1, int fq, int t, const float* __restrict__ rope) {
    const int pos = (fq >> 1) ? (t & 63) : (t >> 6);
    rope4(v0, fq, rope + pos * 16); asm volatile("" ::: "memory"); rope4(v1, fq, rope + pos * 16 + 8);
}

struct EpiP2a {
    static constexpr bool PERM = true, AFTER_DRAIN = false;
    unsigned char* ws;
    __device__ __forceinline__ void operator()(const f32x4 (&acc)[2][2][4][2], const Unit& u, int wr, int wc, int fr, int fq) const {
        asm volatile("" : "+v"(fr), "+v"(fq));
        const int row0 = u.pm * BM + wr * 64 + fr, col0 = u.pn * BM + wc * 32 + 8 * fq; const bool act = u.pm >= 6; bf16_t* const UT = (bf16_t*)(ws + WS_UT);
#pragma unroll
        for (int ai = 0; ai < 2; ++ai)
#pragma unroll
            for (int m = 0; m < 4; ++m) { bf16_t* rowp = UT + (size_t)(row0 + ai * HALF + m * 16) * NTOK + col0;
#pragma unroll
                for (int bj = 0; bj < 2; ++bj) { f32x4 v0 = acc[ai][bj][m][0], v1 = acc[ai][bj][m][1]; if (act) { v0 = silu4(v0); v1 = silu4(v1); }
                    *(u32x4*)(rowp + bj * HALF) = pack8(v0, v1); } }
    }
};
struct EpiP2b {
    static constexpr bool PERM = true, AFTER_DRAIN = false;
    unsigned char* ws; float* out; const float *qg, *kvg;
    __device__ __forceinline__ void operator()(const f32x4 (&acc)[2][2][4][2], const Unit& u, int wr, int wc, int fr, int fq) const {
        asm volatile("" : "+v"(fr), "+v"(fq));
        const int rowt = u.pm * BM; const bool samp = u.pm >= 16;
        const int kvb = samp ? (NPR + ((u.pm - 16) >> 4) * LKS + PAST + ((u.pm - 16) & 15) * BM) : rowt;
        const int rl0 = wr * 64 + fr, cl0 = wc * 32 + 8 * fq;
        bf16_t* const CQ = (bf16_t*)(ws + WS_CQ); bf16_t* const CKV = (bf16_t*)(ws + WS_CKV); bf16_t* const SGB = (bf16_t*)(ws + WS_SGB); bf16_t* const KR = (bf16_t*)(ws + WS_KR);
        float* const SSQQ = (float*)(ws + WS_SSQQ); float* const SSQKV = (float*)(ws + WS_SSQKV); const float* const rope = (const float*)(ws + WS_ROPE);
        float* const st_ckv = out + (size_t)NTOK * DM; float* const st_krope = st_ckv + (size_t)NPR * 256;
        if (u.pn <= 1) {
            const bool isq = (u.pn == 0);
            const float* gv = isq ? qg : kvg; bf16_t* dst = isq ? CQ : CKV; float* ssq = isq ? SSQQ : SSQKV; const int rb = isq ? rowt : kvb;
            f32x4 g[2][2];
#pragma unroll
            for (int bj = 0; bj < 2; ++bj) { g[bj][0] = *(const f32x4*)(gv + bj * HALF + cl0); g[bj][1] = *(const f32x4*)(gv + bj * HALF + cl0 + 4); }
#pragma unroll
            for (int ai = 0; ai < 2; ++ai)
#pragma unroll
                for (int m = 0; m < 4; ++m) { const int rl = rl0 + ai * HALF + m * 16;
                    float s = 0.f;
#pragma unroll
                    for (int bj = 0; bj < 2; ++bj)
#pragma unroll
                        for (int n = 0; n < 2; ++n) { const f32x4 x = acc[ai][bj][m][n]; s += (x[0] * x[0] + x[1] * x[1]) + (x[2] * x[2] + x[3] * x[3]); }
                    s += __shfl_xor(s, 16); s += __shfl_xor(s, 32);
                    if (fq == 0) ssq[(size_t)(rb + rl) * 4 + wc] = s;
#pragma unroll
                    for (int bj = 0; bj < 2; ++bj) { const f32x4 v0 = acc[ai][bj][m][0] * g[bj][0], v1 = acc[ai][bj][m][1] * g[bj][1];
                        *(u32x4*)(dst + (size_t)(rb + rl) * 256 + bj * HALF + cl0) = pack8(v0, v1);
                        if (!isq && !samp) { float* sp = st_ckv + (size_t)(rowt + rl) * 256 + bj * HALF + cl0; *(f32x4*)sp = v0; *(f32x4*)(sp + 4) = v1; } } }
        } else if (u.pn <= 3) {
            const int cb = (u.pn - 2) * BM + cl0;
#pragma unroll
            for (int ai = 0; ai < 2; ++ai)
#pragma unroll
                for (int m = 0; m < 4; ++m) { bf16_t* rowp = SGB + (size_t)(rowt + rl0 + ai * HALF + m * 16) * 512 + cb;
#pragma unroll
                    for (int bj = 0; bj < 2; ++bj) *(u32x4*)(rowp + bj * HALF) = pack8(silu4(acc[ai][bj][m][0]), silu4(acc[ai][bj][m][1])); }
        } else if (wc == 0) {
#pragma unroll
            for (int ai = 0; ai < 2; ++ai)
#pragma unroll
                for (int m = 0; m < 4; ++m) { const int rl = rl0 + ai * HALF + m * 16; f32x4 v0 = acc[ai][0][m][0], v1 = acc[ai][0][m][1];
                    if (!samp) { float* sp = st_krope + (size_t)(rowt + rl) * 32 + 8 * fq; *(f32x4*)sp = v0; *(f32x4*)(sp + 4) = v1; }
                    else rope8(v0, v1, fq, ((u.pm - 16) & 15) * BM + rl, rope);
                    *(u32x4*)(KR + (size_t)(kvb + rl) * 32 + 8 * fq) = pack8(v0, v1); }
        }
    }
};
struct EpiP3q {
    static constexpr bool PERM = true, AFTER_DRAIN = false;
    unsigned char* ws;
    __device__ __forceinline__ void operator()(const f32x4 (&acc)[2][2][4][2], const Unit& u, int wr, int wc, int fr, int fq) const {
        asm volatile("" : "+v"(fr), "+v"(fq));
        const int rowt = u.pm * BM; const bool samp = u.pm >= 16; const int rl0 = wr * 64 + fr, cl0 = u.pn * BM + wc * 32 + 8 * fq;
        bf16_t* const Q = (bf16_t*)(ws + WS_Q); const float* const SSQQ = (const float*)(ws + WS_SSQQ); const float* const rope = (const float*)(ws + WS_ROPE); constexpr float scale = ATTN_SCALE_LOG2E;
#pragma unroll
        for (int ai = 0; ai < 2; ++ai)
#pragma unroll
            for (int m = 0; m < 4; ++m) { const int rl = rl0 + ai * HALF + m * 16; const f32x4 s4 = *(const f32x4*)(SSQQ + (size_t)(rowt + rl) * 4);
                const float rs = __builtin_amdgcn_rsqf(((s4[0] + s4[1]) + (s4[2] + s4[3])) * (1.0f / 256.0f) + EPS) * scale;
#pragma unroll
                for (int bj = 0; bj < 2; ++bj) { f32x4 v0 = acc[ai][bj][m][0] * rs, v1 = acc[ai][bj][m][1] * rs;
                    const int g32 = u.pn * 8 + bj * 4 + wc;
                    if (samp && (g32 % 3) == 2) rope8(v0, v1, fq, ((u.pm - 16) & 15) * BM + rl, rope);
                    *(u32x4*)(Q + (size_t)(rowt + rl) * 768 + bj * HALF + cl0) = pack8(v0, v1); }
                asm volatile("" ::: "memory"); }
    }
};
struct EpiP3k {
    static constexpr bool PERM = true, AFTER_DRAIN = false;
    unsigned char* ws;
    __device__ __forceinline__ void operator()(const f32x4 (&acc)[2][2][4][2], const Unit& u, int wr, int wc, int fr, int fq) const {
        asm volatile("" : "+v"(fr), "+v"(fq));
        bf16_t* const KN = (bf16_t*)(ws + WS_KN); const float* const SSQKV = (const float*)(ws + WS_SSQKV);
        const int rowt = u.pm * BM; const bool cache = (u.pm >= 16) && (((u.pm - 16) % 18) < 2); const int rl0 = wr * 64 + fr, cl0 = u.pn * BM + wc * 32 + 8 * fq;
#pragma unroll
        for (int ai = 0; ai < 2; ++ai)
#pragma unroll
            for (int m = 0; m < 4; ++m) { const int rl = rl0 + ai * HALF + m * 16; float rs = 1.0f;
                if (!cache) { const f32x4 s4 = *(const f32x4*)(SSQKV + (size_t)(rowt + rl) * 4); rs = __builtin_amdgcn_rsqf(((s4[0] + s4[1]) + (s4[2] + s4[3])) * (1.0f / 256.0f) + EPS); }
#pragma unroll
                for (int bj = 0; bj < 2; ++bj) *(u32x4*)(KN + (size_t)(rowt + rl) * 512 + bj * HALF + cl0) = pack8(acc[ai][bj][m][0] * rs, acc[ai][bj][m][1] * rs);
                asm volatile("" ::: "memory"); }
    }
};
struct EpiP3v {
    static constexpr bool PERM = true, AFTER_DRAIN = false;
    unsigned char* ws;
    __device__ __forceinline__ void operator()(const f32x4 (&acc)[2][2][4][2], const Unit& u, int wr, int wc, int fr, int fq) const {
        asm volatile("" : "+v"(fr), "+v"(fq));
        bf16_t* const VT = (bf16_t*)(ws + WS_VT); const float* const SSQKV = (const float*)(ws + WS_SSQKV);
        const bool cache = (u.pn >= 16) && (((u.pn - 16) % 18) < 2); const int row0 = u.pm * BM + wr * 64 + fr, col0 = u.pn * BM + wc * 32 + 8 * fq;
#pragma unroll
        for (int bj = 0; bj < 2; ++bj) { f32x4 r0 = {1.f, 1.f, 1.f, 1.f}, r1 = {1.f, 1.f, 1.f, 1.f};
            if (!cache) {
#pragma unroll
                for (int e = 0; e < 4; ++e) { const f32x4 a = *(const f32x4*)(SSQKV + (size_t)(col0 + bj * HALF + e) * 4), b = *(const f32x4*)(SSQKV + (size_t)(col0 + bj * HALF + 4 + e) * 4);
                    r0[e] = __builtin_amdgcn_rsqf(((a[0] + a[1]) + (a[2] + a[3])) * (1.0f / 256.0f) + EPS); r1[e] = __builtin_amdgcn_rsqf(((b[0] + b[1]) + (b[2] + b[3])) * (1.0f / 256.0f) + EPS);
                    asm volatile("" ::: "memory"); } }
#pragma unroll
            for (int ai = 0; ai < 2; ++ai)
#pragma unroll
                for (int m = 0; m < 4; ++m) *(u32x4*)(VT + (size_t)(row0 + ai * HALF + m * 16) * NKV + col0 + bj * HALF) = pack8(acc[ai][bj][m][0] * r0, acc[ai][bj][m][1] * r1); }
    }
};
struct EpiRes {
    static constexpr bool PERM = false, AFTER_DRAIN = false;
    const float* xp; const float* xs; float* xout; const float* gate;
    __device__ __forceinline__ void operator()(const f32x4 (&acc)[2][2][4][2], const Unit& u, int wr, int wc, int fr, int fq) const {
        asm volatile("" : "+v"(fr), "+v"(fq));
        const int rowt = u.pm * BM; const bool samp = u.pm >= 16; const int cond = samp ? 1 + ((u.pm - 16) >> 4) : 0;
        const float* xin = samp ? xs + (size_t)(rowt - NPR) * DM : xp + (size_t)rowt * DM; const float* gp = gate + cond * 3072;
        const int rl0 = wr * 64 + fr, col0 = u.pn * BM + wc * 32 + 4 * fq;
#pragma unroll
        for (int bj = 0; bj < 2; ++bj)
#pragma unroll
            for (int n = 0; n < 2; ++n) { const int c = col0 + bj * HALF + n * 16; const f32x4 gt = *(const f32x4*)(gp + c);
#pragma unroll
                for (int ai = 0; ai < 2; ++ai)
#pragma unroll
                    for (int m = 0; m < 4; ++m) { const int rl = rl0 + ai * HALF + m * 16; const f32x4 xi = *(const f32x4*)(xin + (size_t)rl * DM + c);
                        *(f32x4*)(xout + (size_t)(rowt + rl) * DM + c) = xi + gt * acc[ai][bj][m][n]; } }
    }
};
struct EpiP7 {
    static constexpr bool PERM = true, AFTER_DRAIN = false;
    unsigned char* ws;
    __device__ __forceinline__ void operator()(const f32x4 (&acc)[2][2][4][2], const Unit& u, int wr, int wc, int fr, int fq) const {
        asm volatile("" : "+v"(fr), "+v"(fq));
        const int part = u.pn >> 2; bf16_t* dst = (bf16_t*)(ws + WS_A) + (size_t)part * (size_t)(20u << 20); const bool act = part == 2;
        const int row0 = u.pm * BM + wr * 64 + fr, col0 = (u.pn & 3) * BM + wc * 32 + 8 * fq;
#pragma unroll
        for (int ai = 0; ai < 2; ++ai)
#pragma unroll
            for (int m = 0; m < 4; ++m) { bf16_t* rowp = dst + (size_t)(row0 + ai * HALF + m * 16) * DM + col0;
#pragma unroll
                for (int bj = 0; bj < 2; ++bj) { f32x4 v0 = acc[ai][bj][m][0], v1 = acc[ai][bj][m][1]; if (act) { v0 = silu4(v0); v1 = silu4(v1); }
                    *(u32x4*)(rowp + bj * HALF) = pack8(v0, v1); } }
    }
};

template <class Epi, class Sched, bool ALIGN_EPI = false, bool SP2 = false>
__device__ __forceinline__ void gemm_phase(PG8_LAS unsigned char* lds, const Gemm g, const Sched& S, const Epi& E, const int wid  ) {
    const int lane = (int)__builtin_amdgcn_mbcnt_hi(~0u, __builtin_amdgcn_mbcnt_lo(~0u, 0u)), tid = wid * 64 + lane, wr = wid >> 2, wc = wid & 3, fr = lane & 15, fq = lane >> 4;
    const int K = g.K, nt = K / BK;
    unsigned voffA[2], voffB[2];
#pragma unroll
    for (int i = 0; i < 2; ++i) { int R, C; stage_rc(tid * 16 + i * 8192, R, C); const int Rb = Epi::PERM ? ((R & ~31) + perm32(R & 31)) : R;
        voffA[i] = (unsigned)(R * K + C) * 2u; voffB[i] = (unsigned)(Rb * K + C) * 2u; }
    const size_t kstep = (size_t)(BK * 2);
    const size_t hstep = (size_t)HALF * K * 2;
    const size_t tstep = 2 * hstep;
    const unsigned ldsw = (unsigned)wid * 1024u;
    const int aoff = lds_byte(wr * 64 + fr, fq * 8), boff = lds_byte(wc * 32 + fr, fq * 8);
#define PG8_SA(b, h) (((b) * 2 + (h)) * HTB)
#define PG8_SB(b, h) ((4 + (b) * 2 + (h)) * HTB)
#define PG8_STAGE(bufoff, gbase, voff) do { _Pragma("unroll") for (int _i = 0; _i < 2; ++_i) \
        __builtin_amdgcn_global_load_lds((const unsigned*)((const char*)(gbase) + (voff)[_i]), (PG8_LAS unsigned*)(lds + (bufoff) + ldsw + _i * 8192), 16, 0, 0); } while (0)
#define PG8_LDA(dst, b, h) do { _Pragma("unroll") for (int m = 0; m < 4; ++m) _Pragma("unroll") for (int k = 0; k < 2; ++k) dst[m][k] = *(const PG8_LAS bf16x8*)(lds + PG8_SA(b, h) + aoff + m * 2048 + k * 1024); } while (0)
#define PG8_LDB(dst, b, h) do { _Pragma("unroll") for (int n = 0; n < 2; ++n) _Pragma("unroll") for (int k = 0; k < 2; ++k) dst[n][k] = *(const PG8_LAS bf16x8*)(lds + PG8_SB(b, h) + boff + n * 2048 + k * 1024); } while (0)
#define PG8_MMA(ai, bj, At, Bt) do { __builtin_amdgcn_s_setprio(1); _Pragma("unroll") for (int m = 0; m < 4; ++m) _Pragma("unroll") for (int n = 0; n < 2; ++n) _Pragma("unroll") for (int k = 0; k < 2; ++k) \
        acc[ai][bj][m][n] = __builtin_amdgcn_mfma_f32_16x16x32_bf16(Bt[n][k], At[m][k], acc[ai][bj][m][n], 0, 0, 0); __builtin_amdgcn_s_setprio(0); } while (0)
#define PG8_WAIT_V(n) asm volatile("s_waitcnt vmcnt(" #n ")" ::: "memory")
#define PG8_WAIT_L(n) asm volatile("s_waitcnt lgkmcnt(" #n ")" ::: "memory")
#define PG8_BAR __builtin_amdgcn_s_barrier()
#define PG8_SCHED __builtin_amdgcn_sched_barrier(0)
    Unit cur, nxt; int ui = 0;
    if (!S.next(0, cur)) return;
    f32x4 acc[2][2][4][2];
#pragma unroll
    for (int a = 0; a < 2; ++a)
#pragma unroll
        for (int b = 0; b < 2; ++b)
#pragma unroll
            for (int m = 0; m < 4; ++m)
#pragma unroll
                for (int n = 0; n < 2; ++n) acc[a][b][m][n] = (f32x4){0.f, 0.f, 0.f, 0.f};
    bf16x8 At[4][2], B0[2][2], B1[2][2];
    const char* cA = (const char*)g.A + (size_t)cur.pm * tstep; const char* cB = (const char*)g.Bt + (size_t)cur.pn * tstep;
    S.a_ready(cur);
    if constexpr (SP2) {
        PG8_STAGE(PG8_SB(0, 0), cB, voffB); PG8_STAGE(PG8_SB(0, 1), cB + hstep, voffB); PG8_STAGE(PG8_SA(0, 0), cA, voffA); PG8_STAGE(PG8_SA(0, 1), cA + hstep, voffA);
        if (wr == 1) PG8_BAR;
        PG8_WAIT_V(2); PG8_BAR;
        PG8_STAGE(PG8_SB(1, 0), cB + kstep, voffB); PG8_STAGE(PG8_SA(1, 0), cA + kstep, voffA); PG8_STAGE(PG8_SB(1, 1), cB + hstep + kstep, voffB);
        PG8_WAIT_V(6); PG8_BAR;
    } else {
        PG8_STAGE(PG8_SB(0, 0), cB, voffB); PG8_STAGE(PG8_SA(0, 0), cA, voffA); PG8_STAGE(PG8_SB(0, 1), cB + hstep, voffB); PG8_STAGE(PG8_SA(0, 1), cA + hstep, voffA);
        if (wr == 1) PG8_BAR;
        PG8_WAIT_V(4); PG8_BAR;
        PG8_STAGE(PG8_SB(1, 0), cB + kstep, voffB); PG8_STAGE(PG8_SA(1, 0), cA + kstep, voffA); PG8_STAGE(PG8_SB(1, 1), cB + hstep + kstep, voffB);
        PG8_WAIT_V(6); PG8_BAR;
    }
    for (;;) {
        const bool has_next = S.next(ui + 1, nxt);
        const char* nA = has_next ? (const char*)g.A + (size_t)nxt.pm * tstep : cA; const char* nB = has_next ? (const char*)g.Bt + (size_t)nxt.pn * tstep : cB;
        for (int t = 0; t < nt; t += 2) {
            const bool last = (t == nt - 2);
            const char* a1 = cA + (size_t)(t + 1) * kstep;
            const char* a2 = last ? nA : cA + (size_t)(t + 2) * kstep; const char* b2 = last ? nB : cB + (size_t)(t + 2) * kstep;
            const char* a3 = a2 + kstep; const char* b3 = b2 + kstep;
            if (last && has_next) S.a_ready(nxt);
            if constexpr (SP2) {
            PG8_LDB(B0, 0, 0); PG8_LDB(B1, 0, 1); PG8_SCHED; PG8_LDA(At, 0, 0); PG8_STAGE(PG8_SA(1, 1), a1 + hstep, voffA);
            PG8_WAIT_V(8); PG8_WAIT_L(0); PG8_BAR; PG8_MMA(0, 0, At, B0); PG8_MMA(0, 1, At, B1); PG8_BAR; PG8_SCHED;
            PG8_LDA(At, 0, 1); PG8_STAGE(PG8_SB(0, 0), b2, voffB); PG8_STAGE(PG8_SB(0, 1), b2 + hstep, voffB); PG8_STAGE(PG8_SA(0, 0), a2, voffA);
            PG8_WAIT_V(8); PG8_WAIT_L(0); PG8_BAR; PG8_MMA(1, 0, At, B0); PG8_MMA(1, 1, At, B1); PG8_BAR; PG8_SCHED;
            PG8_LDB(B0, 1, 0); PG8_LDB(B1, 1, 1); PG8_SCHED; PG8_LDA(At, 1, 0); PG8_STAGE(PG8_SA(0, 1), a2 + hstep, voffA);
            PG8_WAIT_V(8); PG8_WAIT_L(0); PG8_BAR; PG8_MMA(0, 0, At, B0); PG8_MMA(0, 1, At, B1); PG8_BAR; PG8_SCHED;
            PG8_LDA(At, 1, 1); PG8_STAGE(PG8_SB(1, 0), b3, voffB); PG8_STAGE(PG8_SB(1, 1), b3 + hstep, voffB); PG8_STAGE(PG8_SA(1, 0), a3, voffA);
            PG8_WAIT_V(8); PG8_WAIT_L(0); PG8_BAR; PG8_MMA(1, 0, At, B0); PG8_MMA(1, 1, At, B1); PG8_BAR; PG8_SCHED;
            } else {
            PG8_LDB(B0, 0, 0); PG8_SCHED; PG8_LDA(At, 0, 0); PG8_STAGE(PG8_SA(1, 1), a1 + hstep, voffA);
            PG8_WAIT_L(8); PG8_BAR; PG8_WAIT_L(0); PG8_MMA(0, 0, At, B0); PG8_BAR; PG8_SCHED;
            PG8_LDB(B1, 0, 1); PG8_STAGE(PG8_SB(0, 0), b2, voffB);
            PG8_BAR; PG8_WAIT_L(0); PG8_MMA(0, 1, At, B1); PG8_BAR;
            PG8_LDA(At, 0, 1); PG8_STAGE(PG8_SA(0, 0), a2, voffA);
            PG8_BAR; PG8_WAIT_L(0); PG8_MMA(1, 0, At, B0); PG8_BAR; PG8_SCHED;
            PG8_STAGE(PG8_SB(0, 1), b2 + hstep, voffB);
            PG8_WAIT_V(6); PG8_BAR; PG8_MMA(1, 1, At, B1); PG8_BAR;
            PG8_LDB(B0, 1, 0); PG8_SCHED; PG8_LDA(At, 1, 0); PG8_STAGE(PG8_SA(0, 1), a2 + hstep, voffA);
            PG8_WAIT_L(8); PG8_BAR; PG8_WAIT_L(0); PG8_MMA(0, 0, At, B0); PG8_BAR; PG8_SCHED;
            PG8_LDB(B1, 1, 1); PG8_STAGE(PG8_SB(1, 0), b3, voffB);
            PG8_BAR; PG8_WAIT_L(0); PG8_MMA(0, 1, At, B1); PG8_BAR;
            PG8_LDA(At, 1, 1); PG8_STAGE(PG8_SA(1, 0), a3, voffA);
            PG8_BAR; PG8_WAIT_L(0); PG8_MMA(1, 0, At, B0); PG8_BAR; PG8_SCHED;
            PG8_STAGE(PG8_SB(1, 1), b3 + hstep, voffB);
            PG8_WAIT_V(6); PG8_BAR; PG8_MMA(1, 1, At, B1); PG8_BAR;
            }
        }
        if constexpr (ALIGN_EPI) { if (wr == 0) PG8_BAR; }
        if constexpr (!Epi::AFTER_DRAIN) { E(acc, cur, wr, wc, fr, fq); S.done(cur); }
        if (!has_next) break;
#pragma unroll
        for (int a = 0; a < 2; ++a)
#pragma unroll
            for (int b = 0; b < 2; ++b)
#pragma unroll
                for (int m = 0; m < 4; ++m)
#pragma unroll
                    for (int n = 0; n < 2; ++n) acc[a][b][m][n] = (f32x4){0.f, 0.f, 0.f, 0.f};
        cur = nxt; cA = nA; cB = nB; ++ui;
        if constexpr (ALIGN_EPI) { if (wr == 1) PG8_BAR; }
    }
    PG8_WAIT_V(0);
    if constexpr (!ALIGN_EPI) { if (wr == 0) PG8_BAR; }
    PG8_BAR;
    if constexpr (Epi::AFTER_DRAIN) { E.fused(acc, cur, wr, wc, fr, fq, lds, wid, lane); S.done(cur); }
#undef PG8_SA
#undef PG8_SB
#undef PG8_STAGE
#undef PG8_LDA
#undef PG8_LDB
#undef PG8_MMA
#undef PG8_WAIT_V
#undef PG8_WAIT_L
#undef PG8_BAR
#undef PG8_SCHED
}
}
#define GAS __attribute__((address_space(1)))
#define LAS __attribute__((address_space(3)))
typedef unsigned short bf16;
typedef unsigned v4u __attribute__((ext_vector_type(4)));
typedef float f32x4 __attribute__((ext_vector_type(4)));
typedef short bf16x8 __attribute__((ext_vector_type(8)));
typedef GAS unsigned gu32;
typedef GAS unsigned long long gu64;
#define RLX_AGENT __ATOMIC_RELAXED, __HIP_MEMORY_SCOPE_AGENT
#define LDS_WAIT() asm volatile("s_waitcnt lgkmcnt(0)" ::: "memory")
#define VM_WAIT() asm volatile("s_waitcnt vmcnt(0)" ::: "memory")
__device__ __forceinline__ unsigned long long rt() { return __builtin_amdgcn_s_memrealtime(); }

#define XB_TMO      128
#define XB_XCNT(j)  (256  + 64 * (j))
#define XB_XSUB(j)  (1280 + 64 * (j))
#define XB_XGEN(j)  (2304 + 64 * (j))
#define XB_TOP      3328
#define XB_TOPGEN   3392
#define XCD_BAR_WORDS 3456
#define XB_SPIN_CAP (1u << 18)

__device__ __forceinline__ unsigned xb_ld(unsigned* p)              { return __hip_atomic_load(p, __ATOMIC_RELAXED, __HIP_MEMORY_SCOPE_AGENT); }
__device__ __forceinline__ unsigned xb_add(unsigned* p, unsigned v) { return __hip_atomic_fetch_add(p, v, __ATOMIC_RELAXED, __HIP_MEMORY_SCOPE_AGENT); }
__device__ __forceinline__ unsigned xb_xcc_id() { return (unsigned)__builtin_amdgcn_s_getreg((3 << 11) | 20) & 0xFu; }
#define XB_SPIN(cond, bar) do { unsigned _sp = 0; while (cond) { __builtin_amdgcn_s_sleep(1); \
    if ((++_sp & 255u) == 0u) { if (xb_ld(&(bar)[XB_TMO])) break; if (_sp > XB_SPIN_CAP) { atomicAdd(&(bar)[XB_TMO], 1u); break; } } } } while (0)

struct XcdBarrier {
    unsigned* bar; unsigned x;
    volatile LAS unsigned* st;
};

__device__ __forceinline__ XcdBarrier xcd_barrier_post(unsigned* bar, volatile LAS unsigned* st, const bool t0) {
    XcdBarrier b; b.bar = bar; b.x = xb_xcc_id(); b.st = st;
    if (t0) (void)xb_add(&bar[XB_XCNT(b.x)], 1u);
    return b;
}
__device__ __forceinline__ void xcd_barrier_complete(unsigned* bar, unsigned x, unsigned& nloc, unsigned& nx) {
    const unsigned G = gridDim.x * gridDim.y * gridDim.z;
    unsigned sum, cnt, mine, sp = 0u;
    for (;;) {
        sum = 0u; cnt = 0u; mine = 0u;
#pragma unroll
        for (unsigned j = 0; j < 16; ++j) { const unsigned c = xb_ld(&bar[XB_XCNT(j)]); sum += c; cnt += (c > 0u) ? 1u : 0u; mine = (j == x) ? c : mine; }
        if (sum == G) break;
        __builtin_amdgcn_s_sleep(1);
        if ((++sp & 255u) == 0u) { if (xb_ld(&bar[XB_TMO])) break; if (sp > XB_SPIN_CAP) { atomicAdd(&bar[XB_TMO], 1u); break; } }
    }
    nloc = mine > 0u ? mine : 1u; nx = cnt > 0u ? cnt : 1u;
}

__device__ __forceinline__ void xcd_barrier(const XcdBarrier& b, const bool t0) {
    asm volatile("s_waitcnt vmcnt(0)" ::: "memory");
    __syncthreads();
    if (t0) {
        unsigned* bar = b.bar;
        __builtin_amdgcn_s_waitcnt(0);
        unsigned nloc = b.st[0], nx = b.st[1];
        if (nloc == 0u) { xcd_barrier_complete(bar, b.x, nloc, nx); b.st[0] = nloc; b.st[1] = nx; }
        const unsigned old = xb_add(&bar[XB_XSUB(b.x)], 1u);
        const unsigned gen = old / nloc;
        if (old + 1u == (gen + 1u) * nloc) {
            __builtin_amdgcn_fence(__ATOMIC_RELEASE, "agent");
            asm volatile("s_waitcnt vmcnt(0)" ::: "memory");
            const unsigned og = xb_add(&bar[XB_TOP], 1u);
            const unsigned tg = og / nx;
            if (og + 1u == (tg + 1u) * nx) xb_add(&bar[XB_TOPGEN], 1u);
            else XB_SPIN(xb_ld(&bar[XB_TOPGEN]) == tg, bar);
            __builtin_amdgcn_fence(__ATOMIC_ACQUIRE, "agent");
            xb_add(&bar[XB_XGEN(b.x)], 1u);
            asm volatile("s_waitcnt vmcnt(0)" ::: "memory");
        } else {
            XB_SPIN(xb_ld(&bar[XB_XGEN(b.x)]) == gen, bar);
            __builtin_amdgcn_fence(__ATOMIC_ACQUIRE, "agent");
            asm volatile("s_waitcnt vmcnt(0)" ::: "memory");
        }
    }
    __syncthreads();
}


constexpr int NWAVES = 8;
constexpr int RING_BYTES = 131072;
constexpr int LDSCTL_OFF = RING_BYTES, MISC_OFF = LDSCTL_OFF + 320;
constexpr int LDS_BYTES = 147456;
constexpr int CW_TMO = 0, CW_CODE = 1, CW_BAR = 4096;
static_assert((CW_BAR + 3456) * 4 <= (int)CTL_ZERO_BYTES, "ctl");

struct Args { const float* in[27]; float* out; unsigned char* ws; int ph_lo, ph_hi, grid, pad; };
typedef const Args __attribute__((address_space(4)))* ArgsP;
extern __shared__ __attribute__((aligned(16))) unsigned char g_lds[];
constexpr int CTXW_OFF = LDSCTL_OFF;
struct Ctx { ArgsP a; int wave, bid; };
__device__ __forceinline__ unsigned hw_slot() { return (unsigned)__builtin_amdgcn_s_getreg((5 << 11) | 4) & 63u; }
__device__ __forceinline__ Ctx get_ctx() {
    volatile LAS unsigned* cw = (volatile LAS unsigned*)((LAS unsigned char*)g_lds + CTXW_OFF);
    Ctx c; c.wave = __builtin_amdgcn_readfirstlane((int)cw[hw_slot()]); c.bid = __builtin_amdgcn_readfirstlane((int)cw[64]);
    const unsigned lo = (unsigned)__builtin_amdgcn_readfirstlane((int)cw[66]), hi = (unsigned)__builtin_amdgcn_readfirstlane((int)cw[67]);
    c.a = (ArgsP)(uintptr_t)(((unsigned long long)hi << 32) | lo); return c;
}
#define LANE_ID() ((int)__builtin_amdgcn_mbcnt_hi(~0u, __builtin_amdgcn_mbcnt_lo(~0u, 0u)))
enum { I_XP = 0, I_XS, I_C, I_CCKV, I_CKR, I_CCTX, I_NORMG, I_WMOD, I_BMOD, I_WINE, I_CONVW, I_CONVB, I_FW1, I_FB1, I_FW2, I_FB2, I_FW3, I_SKIP, I_QG, I_KVG, I_WUQ, I_WUKV, I_WOUTE, I_WINO, I_FNETW, I_WOUTO, I_FINALG };

__device__ __forceinline__ float wave_sum(float v) {
#pragma unroll
    for (int o = 1; o < 64; o <<= 1) v += __shfl_xor(v, o);
    return v;
}

__device__ __forceinline__ void transpose_item(const float* __restrict__ src, int pitch, int k0, int n0, bf16* __restrict__ dst, int K, float* scr, int lane) {
#pragma unroll 8
    for (int i = 0; i < 32; ++i) { const int kk = 2 * i + (lane >> 5); scr[kk * 33 + (lane & 31)] = src[(size_t)(k0 + kk) * pitch + n0 + (lane & 31)]; }
    __builtin_amdgcn_s_waitcnt(0xc07f); asm volatile("" ::: "memory");
    const int c = lane & 7;
#pragma unroll
    for (int j = 0; j < 4; ++j) { const int n = (lane >> 3) + 8 * j; const float* s = scr + (8 * c) * 33 + n;
        u32x4 o; o.x = pk2(s[0 * 33], s[1 * 33]); o.y = pk2(s[2 * 33], s[3 * 33]); o.z = pk2(s[4 * 33], s[5 * 33]); o.w = pk2(s[6 * 33], s[7 * 33]);
        *(u32x4*)(dst + (size_t)n * K + k0 + 8 * c) = o; }
    __builtin_amdgcn_s_waitcnt(0xc07f); asm volatile("" ::: "memory");
}

#define P0_CTX const Ctx cx_ = get_ctx(); ArgsP a = cx_.a; const int G = a->grid, bid = cx_.bid; const int wave = cx_.wave, lane = LANE_ID(), tid = wave * 64 + lane; \
    unsigned char* const ws = a->ws; float* const lf = (float*)lds; (void)G; (void)bid; (void)lane; (void)wave; (void)ws; (void)lf
__device__ __forceinline__ void phase0(unsigned char* lds) {
    { P0_CTX;
        float* sc = lf; float* red = lf + 5 * 1024; float* MOD = (float*)(ws + WS_MOD);
        for (int task = bid; task < 192; task += G) {
            const int l = task / 96, n0 = (task % 96) * 32;
            __syncthreads();
            for (int i = tid; i < 5 * 1024; i += 512) { const int cnd = i >> 10, k = i & 1023; const float x = cnd == 0 ? a->in[I_CCTX][k] : a->in[I_C][(cnd - 1) * 1024 + k]; sc[i] = x / (1.0f + expf(-x)); }
            __syncthreads();
            const int col = tid & 31, ks = tid >> 5; float acc[5] = {0.f, 0.f, 0.f, 0.f, 0.f};
            const float* w = a->in[I_WMOD] + (size_t)l * 1024 * 3072 + n0 + col;
#pragma unroll 8
            for (int k = ks * 64; k < ks * 64 + 64; ++k) { const float wv = w[(size_t)k * 3072];
#pragma unroll
                for (int cnd = 0; cnd < 5; ++cnd) acc[cnd] += sc[cnd * 1024 + k] * wv; }
#pragma unroll
            for (int cnd = 0; cnd < 5; ++cnd) red[(ks * 5 + cnd) * 32 + col] = acc[cnd];
            __syncthreads();
            if (tid < 160) { const int cnd = tid >> 5, cc = tid & 31; float s = a->in[I_BMOD][l * 3072 + n0 + cc];
                for (int k2 = 0; k2 < 16; ++k2) s += red[(k2 * 5 + cnd) * 32 + cc];
                MOD[(l * 5 + cnd) * 3072 + n0 + cc] = s; }
        }
    }
    { P0_CTX;
        float* z = lf; float* h1 = lf + 528; float* h2 = h1 + 1024; float* PS = (float*)(ws + WS_PS);
        const float *w1 = a->in[I_FW1], *b1 = a->in[I_FB1], *w2 = a->in[I_FW2], *b2 = a->in[I_FB2], *w3 = a->in[I_FW3];
        for (int task = bid; task < 272; task += G) {
            const int sel = task < 256 ? 0 : 1, chunk = sel ? task - 256 : task, L = sel ? 256 : 4096, p0 = chunk * 16;
            bf16* KF = (bf16*)(ws + (sel ? WS_KF1 : WS_KF0));
            __syncthreads();
            for (int o = tid; o < 16 * 33; o += 512) { const int p = o / 33, i = o % 33, pos = p0 + p; float v;
                if (i == 0) v = (float)((double)pos / (double)(L - 1));
                else { const int bi = (i - 1) & 15; const double f = 1e-4 + (double)bi * ((15.0 - 1e-4) / 15.0), w = 6.283185307179586476925 * (double)pos / (double)L;
                    v = (i <= 16) ? (float)cos(f * w) : (float)(-sin(f * w)); }
                z[p * 33 + i] = v; }
            __syncthreads();
            for (int o = tid; o < 1024; o += 512) { const int p = o >> 6, j = o & 63; float s = b1[j];
                for (int i = 0; i < 33; ++i) s += z[p * 33 + i] * w1[i * 64 + j];
                h1[o] = sinf(s); }
            __syncthreads();
            for (int o = tid; o < 1024; o += 512) { const int p = o >> 6, j = o & 63; float s = b2[j];
                for (int i = 0; i < 64; ++i) s += h1[p * 64 + i] * w2[i * 64 + j];
                h2[o] = sinf(s); }
            __syncthreads();
#pragma unroll 1
            for (int q = 0; q < 2; ++q) { const int n = tid + 512 * q, c = tid; float acc[16];
#pragma unroll
                for (int p = 0; p < 16; ++p) acc[p] = 0.f;
                for (int j = 0; j < 64; ++j) { const float wv = w3[j * 1024 + n];
#pragma unroll
                    for (int p = 0; p < 16; ++p) acc[p] += h2[p * 64 + j] * wv; }
                const float delta = 3.0701134573253946f + (float)c * ((15.350567286626973f - 3.0701134573253946f) / 511.0f); float ps = 0.f;
#pragma unroll
                for (int p = 0; p < 16; ++p) { const int pos = p0 + p; const float t = (float)pos / (float)(L - 1); const float v = acc[p] * expf(-t * delta); ps += fabsf(v);
                    int idx = (q == 0) ? (L + pos) : (L - pos); unsigned hv = f2bf(v); if (q == 1 && pos == 0) { idx = 0; hv = 0u; }
                    KF[(size_t)c * (2 * L) + idx] = (bf16)hv; }
                PS[(size_t)(sel * 256 + chunk) * 1024 + n] = ps; }
        }
    }
    __syncthreads();
    { P0_CTX;
        float* tab = lf;
        if (tid < 128) { tab[2 * tid] = (float)cos(6.283185307179586476925 * (double)tid / 128.0); tab[2 * tid + 1] = (float)sin(6.283185307179586476925 * (double)tid / 128.0); }
        __syncthreads();
        float* PQ = (float*)(ws + WS_PQ); const float* Wf = a->in[I_FNETW];
        for (int idx = bid * 512 + tid; idx < 262144; idx += G * 512) { const int half = idx >> 17, g = (idx >> 14) & 7, c = (idx >> 7) & 127, d = idx & 127; float s = 0.f;
            for (int j = 0; j < 128; ++j) s += tab[2 * ((c * j) & 127) + half] * Wf[(size_t)(g * 128 + j) * 128 + d];
            PQ[idx] = s * 0.08838834764831845f; }
        __syncthreads();
    }
    { P0_CTX;
        float* scr = lf + wave * (64 * 33);
        const int gw = bid * NWAVES + wave, NGW = G * NWAVES;
        for (int it = gw; it < 3312; it += NGW) {
            int r = it, si, pitch, K, kb, nb, n0; size_t doff;
            if (r < 1552) { si = I_WINE; pitch = 3104; K = 1024; kb = r / 97; nb = r % 97; n0 = 32 * nb; const int drow = nb < 80 ? 32 * nb : (nb == 80 ? 3072 : 32 * nb - 32); doff = WS_WT_IN_E + (size_t)drow * 2048; }
            else if ((r -= 1552) < 96) { si = I_WUQ; pitch = 768; K = 256; kb = r / 24; nb = r % 24; n0 = 32 * nb; doff = WS_WT_UQ + (size_t)(32 * nb) * 512; }
            else if ((r -= 96) < 128) { si = I_WUKV; pitch = 1024; K = 256; kb = r / 32; nb = r % 32; n0 = 32 * nb; const int h = nb >> 2, part = nb & 3;
                doff = (part < 2) ? WS_WT_UK + (size_t)(h * 64 + 32 * part) * 512 : WS_WT_UV + (size_t)(h * 64 + 32 * (part - 2)) * 512; }
            else if ((r -= 128) < 512) { si = I_WOUTE; pitch = 1024; K = 1024; kb = r / 32; nb = r % 32; n0 = 32 * nb; doff = WS_WT_OUT_E + (size_t)(32 * nb) * 2048; }
            else if ((r -= 512) < 512) { si = I_WINO; pitch = 2048; K = 1024; kb = r / 32; nb = r % 32; n0 = 1024 + 32 * nb; doff = WS_WT_IN_O + (size_t)(2048 + 32 * nb) * 2048; }
            else { r -= 512; si = I_WOUTO; pitch = 1024; K = 1024; kb = r / 32; nb = r % 32; n0 = 32 * nb; doff = WS_WT_OUT_O + (size_t)(32 * nb) * 2048; }
            transpose_item(a->in[si], pitch, 64 * kb, n0, (bf16*)(ws + doff), K, scr, lane);
        }
    }
    { P0_CTX;
        const int gt = bid * 512 + tid, NT = G * 512;
        { u32x4* zp = (u32x4*)((bf16*)(ws + WS_WT_IN_E) + (size_t)3104 * 1024); for (int i = gt; i < 224 * 1024 / 8; i += NT) zp[i] = (u32x4){0u, 0u, 0u, 0u}; }
        { bf16* CKV = (bf16*)(ws + WS_CKV); const float* src = a->in[I_CCKV];
            for (int i = gt; i < 4 * 512 * 256 / 4; i += NT) { const int e = i * 4, b = e >> 17, p = (e >> 8) & 511, c = e & 255; const f32x4 v = *(const f32x4*)(src + e);
                u32x2 o; o.x = pk2(v[0], v[1]); o.y = pk2(v[2], v[3]); *(u32x2*)(CKV + (size_t)(NPR + b * LKS + p) * 256 + c) = o; } }
        { bf16* KR = (bf16*)(ws + WS_KR); const float* src = a->in[I_CKR];
            for (int i = gt; i < 4 * 512 * 32 / 4; i += NT) { const int e = i * 4, b = e >> 14, p = (e >> 5) & 511, c = e & 31; const f32x4 v = *(const f32x4*)(src + e);
                u32x2 o; o.x = pk2(v[0], v[1]); o.y = pk2(v[2], v[3]); *(u32x2*)(KR + (size_t)(NPR + b * LKS + p) * 32 + c) = o; } }
        { float* rope = (float*)(ws + WS_ROPE);
            for (int i = gt; i < 512; i += NT) { const int pos = i >> 3, f = i & 7; const double ang = (double)pos * pow(10000.0, -(double)f / 8.0); rope[2 * i] = (float)cos(ang); rope[2 * i + 1] = (float)sin(ang); } }
        { float* tw = (float*)(ws + WS_TW);
            for (int i = gt; i < 4096 + 256 + 64; i += NT) { int m, N; if (i < 4096) { m = i; N = 4096; } else if (i < 4352) { m = i - 4096; N = 256; } else { m = i - 4352; N = 64; }
                const double ang = 6.283185307179586476925 * (double)m / (double)N; tw[2 * i] = (float)cos(ang); tw[2 * i + 1] = (float)sin(ang); } }
    }
}

__device__ __forceinline__ void norm_mod_row(const float* __restrict__ xrow, bf16* __restrict__ hrow, const float* __restrict__ g, const float* __restrict__ shift, const float* __restrict__ scale, int lane) {
    f32x4 v[4]; float s = 0.f;
#pragma unroll
    for (int j = 0; j < 4; ++j) { v[j] = *(const f32x4*)(xrow + 4 * lane + 256 * j); s += (v[j][0] * v[j][0] + v[j][1] * v[j][1]) + (v[j][2] * v[j][2] + v[j][3] * v[j][3]); }
    const float rs = 1.0f / sqrtf(wave_sum(s) * (1.0f / 1024.0f) + EPS);
#pragma unroll
    for (int j = 0; j < 4; ++j) { const int c = 4 * lane + 256 * j; const f32x4 gg = *(const f32x4*)(g + c), sh = *(const f32x4*)(shift + c), sc = *(const f32x4*)(scale + c);
        const f32x4 h = (v[j] * rs * gg) * (sc + 1.0f) + sh; u32x2 o; o.x = pk2(h[0], h[1]); o.y = pk2(h[2], h[3]); *(u32x2*)(hrow + c) = o; }
}
__device__ __forceinline__ void norm_mod_phase(ArgsP a, int layer, int lane, int wave, int bid, int G) {
    const float* MOD = (const float*)(a->ws + WS_MOD) + layer * 5 * 3072; const float* g = a->in[I_NORMG] + layer * 1024; bf16* H = (bf16*)(a->ws + WS_H);
    const int gw = bid * NWAVES + wave, NGW = G * NWAVES;
    for (int r = gw; r < NTOK; r += NGW) {
        const int cond = r < NPR ? 0 : 1 + ((r - NPR) >> 12);
        const float* xrow = layer == 0 ? (r < NPR ? a->in[I_XP] + (size_t)r * DM : a->in[I_XS] + (size_t)(r - NPR) * DM) : a->out + (size_t)r * DM;
        norm_mod_row(xrow, H + (size_t)r * DM, g, MOD + cond * 3072, MOD + cond * 3072 + 1024, lane);
    }
}
__device__ __forceinline__ void fnet_fold_phase(ArgsP a, unsigned char* lds, int tid, int bid, int G) {
    float* wu = (float*)lds;
    float* pq = wu + 64 * 128;
    const float* PQ = (const float*)(a->ws + WS_PQ); const float* W = a->in[I_WINO]; bf16* WT = (bf16*)(a->ws + WS_WT_IN_O);
    for (int task = bid; task < 256; task += G) {
        const int half = task >> 7, g = (task >> 4) & 7, k0 = (task & 15) * 64;
        __syncthreads();
        for (int i = tid; i < 64 * 128; i += 512) { const int k = i >> 7, c = i & 127; wu[i] = W[(size_t)(k0 + k) * 2048 + g * 128 + c]; }
        for (int i = tid; i < 128 * 128; i += 512) pq[i] = PQ[(size_t)(half * 8 + g) * 16384 + i];
        __syncthreads();
        const int d = tid & 127, kq = tid >> 7; float acc[16];
#pragma unroll
        for (int i = 0; i < 16; ++i) acc[i] = 0.f;
        for (int c = 0; c < 128; ++c) { const float p = pq[c * 128 + d];
#pragma unroll
            for (int i = 0; i < 16; ++i) acc[i] += wu[(kq * 16 + i) * 128 + c] * p; }
        bf16* dst = WT + (size_t)(half * 1024 + g * 128 + d) * 1024 + k0 + kq * 16;
        u32x4 o0, o1; o0.x = pk2(acc[0], acc[1]); o0.y = pk2(acc[2], acc[3]); o0.z = pk2(acc[4], acc[5]); o0.w = pk2(acc[6], acc[7]);
        o1.x = pk2(acc[8], acc[9]); o1.y = pk2(acc[10], acc[11]); o1.z = pk2(acc[12], acc[13]); o1.w = pk2(acc[14], acc[15]);
        *(u32x4*)dst = o0; *(u32x4*)(dst + 8) = o1;
    }
    __syncthreads();
}
__device__ __forceinline__ void final_norm_phase(ArgsP a, int lane, int wave, int bid, int G) {
    const float* g = a->in[I_FINALG]; const int gw = bid * NWAVES + wave, NGW = G * NWAVES;
    for (int r = gw; r < NTOK; r += NGW) { float* x = a->out + (size_t)r * DM; f32x4 v[4]; float s = 0.f;
#pragma unroll
        for (int j = 0; j < 4; ++j) { v[j] = *(const f32x4*)(x + 4 * lane + 256 * j); s += (v[j][0] * v[j][0] + v[j][1] * v[j][1]) + (v[j][2] * v[j][2] + v[j][3] * v[j][3]); }
        const float rs = 1.0f / sqrtf(wave_sum(s) * (1.0f / 1024.0f) + EPS);
#pragma unroll
        for (int j = 0; j < 4; ++j) { const int c = 4 * lane + 256 * j; *(f32x4*)(x + c) = v[j] * rs * *(const f32x4*)(g + c); } }
}
__device__ __forceinline__ void state_fix_phase(ArgsP a, int tid, int bid, int G) {
    float* st = a->out + (size_t)NTOK * DM; const float* ssq = (const float*)(a->ws + WS_SSQKV);
    for (int i = bid * 512 + tid; i < NPR * 256 / 4; i += G * 512) { const int r = i >> 6; const f32x4 s4 = *(const f32x4*)(ssq + (size_t)r * 4);
        const float rs = 1.0f / sqrtf(((s4[0] + s4[1]) + (s4[2] + s4[3])) * (1.0f / 256.0f) + EPS); f32x4* p = (f32x4*)st + i; *p = *p * rs; }
}

__device__ __forceinline__ float conv3_at(const bf16* __restrict__ row, int tok, int s, int L, float w0, float w1, float w2, float b) {
    float r = b + w1 * bf2f(row[tok]);
    if (s > 0) r += w0 * bf2f(row[tok - 1]);
    if (s < L - 1) r += w2 * bf2f(row[tok + 1]);
    return r;
}
template <bool SAMPLE>
__device__ __forceinline__ void hyena_unit(ArgsP a, unsigned char* lds, int c, int tid, int lane, int wave) {
    constexpr int L = SAMPLE ? LSM : LPR, NB = SAMPLE ? 4 : 16, TOK0 = SAMPLE ? NPR : 0, NCH = L / 16, SEL = SAMPLE ? 0 : 1;
    float* vbuf = (float*)lds;
    float* kf = vbuf + NB * L;
    float* misc = kf + 2 * L;
    const bf16* UT = (const bf16*)(a->ws + WS_UT); bf16* YT = (bf16*)(a->ws + WS_YT);
    const bf16* KF = (const bf16*)(a->ws + (SAMPLE ? WS_KF0 : WS_KF1)) + (size_t)c * (2 * L);
    const float* cw = a->in[I_CONVW]; const float* cb = a->in[I_CONVB];
    __syncthreads();
    if (wave == 0) { const float* PS = (const float*)(a->ws + WS_PS) + (size_t)SEL * 256 * 1024; float s = 0.f;
        for (int ch = lane; ch < NCH; ch += 64) s += PS[(size_t)ch * 1024 + c] + PS[(size_t)ch * 1024 + 512 + c];
        s = wave_sum(s); if (lane == 0) misc[0] = 1.0f / s; }
#pragma unroll 2
    for (int it = 0; it < 2 * L / 512; ++it) { const int i = tid + it * 512; kf[i] = bf2f(KF[i]); }
    {
        const bf16* r1 = UT + (size_t)(512 + c) * NTOK; const bf16* rv = UT + (size_t)(1024 + c) * NTOK;
        const float a0 = cw[512 + c], a1 = cw[1536 + 512 + c], a2 = cw[3072 + 512 + c], ab = cb[512 + c];
        const float v0 = cw[1024 + c], v1 = cw[1536 + 1024 + c], v2 = cw[3072 + 1024 + c], vb = cb[1024 + c];
#pragma unroll 2
        for (int it = 0; it < NB * L / 512; ++it) { const int idx = tid + it * 512, s = idx % L, tok = TOK0 + idx;
            vbuf[idx] = conv3_at(rv, tok, s, L, v0, v1, v2, vb) * conv3_at(r1, tok, s, L, a0, a1, a2, ab); }
    }
    __syncthreads();
    const float sinv = misc[0], skip = a->in[I_SKIP][c];
    const bf16* r0 = UT + (size_t)c * NTOK; const bf16* rg = UT + (size_t)(1536 + c) * NTOK;
    const float x0w0 = cw[c], x0w1 = cw[1536 + c], x0w2 = cw[3072 + c], x0b = cb[c];
    if constexpr (SAMPLE) {
        float acc[8][4];
#pragma unroll
        for (int i = 0; i < 8; ++i)
#pragma unroll
            for (int b = 0; b < 4; ++b) acc[i][b] = 0.f;
        const float* kp = kf + tid + L;
        for (int s = 0; s < L; ++s) { float vb4[4];
#pragma unroll
            for (int b = 0; b < 4; ++b) vb4[b] = vbuf[b * L + s];
#pragma unroll
            for (int i = 0; i < 8; ++i) { const float kv = kp[512 * i - s];
#pragma unroll
                for (int b = 0; b < 4; ++b) acc[i][b] += kv * vb4[b]; } }
#pragma unroll
        for (int i = 0; i < 8; ++i)
#pragma unroll
            for (int b = 0; b < 4; ++b) { const int t = tid + 512 * i, tok = TOK0 + b * L + t;
                const float y = (acc[i][b] * sinv + vbuf[b * L + t] * skip) * conv3_at(r0, tok, t, L, x0w0, x0w1, x0w2, x0b) * bf2f(rg[tok]);
                YT[(size_t)c * NTOK + tok] = (bf16)f2bf(y); }
    } else {
        const int t = tid & 255, bg = tid >> 8; float acc[8];
#pragma unroll
        for (int b = 0; b < 8; ++b) acc[b] = 0.f;
        const float* kp = kf + t + L;
        for (int s = 0; s < L; ++s) { const float kv = kp[-s];
#pragma unroll
            for (int b = 0; b < 8; ++b) acc[b] += kv * vbuf[(bg * 8 + b) * L + s]; }
#pragma unroll
        for (int b = 0; b < 8; ++b) { const int bb = bg * 8 + b, tok = TOK0 + bb * L + t;
            const float y = (acc[b] * sinv + vbuf[bb * L + t] * skip) * conv3_at(r0, tok, t, L, x0w0, x0w1, x0w2, x0b) * bf2f(rg[tok]);
            YT[(size_t)c * NTOK + tok] = (bf16)f2bf(y); }
    }
}

__device__ __forceinline__ int crow(int r, int hi) { return (r & 3) + 8 * (r >> 2) + 4 * hi; }
constexpr int KS_PITCH = 104, VS_PITCH = 68;
constexpr int ATT_KS = 0, ATT_VS = 2 * 64 * KS_PITCH * 2, ATT_ST = ATT_VS + 2 * 64 * VS_PITCH * 2, ATT_ST_PITCH = 72;
__device__ __forceinline__ void attn_unit(ArgsP a, unsigned char* lds, int qrow0, int kvrow0, int Lk, int h, int tid, int lane, int wave) {
    const bf16* Q = (const bf16*)(a->ws + WS_Q); const bf16* KN = (const bf16*)(a->ws + WS_KN); const bf16* KR = (const bf16*)(a->ws + WS_KR);
    const bf16* VT = (const bf16*)(a->ws + WS_VT); const bf16* SGB = (const bf16*)(a->ws + WS_SGB); bf16* Z = (bf16*)(a->ws + WS_Z);
    bf16* Ks = (bf16*)(lds + ATT_KS); bf16* Vs = (bf16*)(lds + ATT_VS); bf16* St = (bf16*)(lds + ATT_ST) + wave * 32 * ATT_ST_PITCH;
    const int r32 = lane & 31, hi = lane >> 5;
    bf16x8 qf[6];
    { const bf16* qp = Q + (size_t)(qrow0 + wave * 32 + r32) * 768 + h * 96 + 8 * hi;
#pragma unroll
        for (int ks = 0; ks < 6; ++ks) qf[ks] = *(const bf16x8*)(qp + 16 * ks); }
    const int kkey = tid >> 3, kch = tid & 7;
    const int rkey = tid >> 2, rch = tid & 3;
    const int vd = tid >> 3, vch = tid & 7;
    const bf16* kn_src = KN + (size_t)(kvrow0 + kkey) * 512 + h * 64 + kch * 8;
    const bf16* kr_src = KR + (size_t)(kvrow0 + (rkey & 63)) * 32 + rch * 8;
    const bf16* vt_src = VT + (size_t)(h * 64 + vd) * NKV + kvrow0 + vch * 8;
    const int NT = Lk / 64;
    u32x4 kreg, rreg, vreg;
    kreg = *(const u32x4*)kn_src; rreg = (tid < 256) ? *(const u32x4*)kr_src : (u32x4){0u, 0u, 0u, 0u}; vreg = *(const u32x4*)vt_src;
    __syncthreads();
    { *(u32x4*)(Ks + kkey * KS_PITCH + kch * 8) = kreg; if (tid < 256) *(u32x4*)(Ks + rkey * KS_PITCH + 64 + rch * 8) = rreg;
      u32x2* vp = (u32x2*)(Vs + vd * VS_PITCH + vch * 8); vp[0] = (u32x2){vreg.x, vreg.y}; vp[1] = (u32x2){vreg.z, vreg.w}; }
    __syncthreads();
    float m_run = -1e30f, l_run = 0.f; f32x16 o0 = {}, o1 = {};
    for (int j = 0; j < NT; ++j) {
        const int buf = j & 1;
        if (j + 1 < NT) { kreg = *(const u32x4*)(kn_src + (size_t)(j + 1) * 64 * 512); if (tid < 256) rreg = *(const u32x4*)(kr_src + (size_t)(j + 1) * 64 * 32); vreg = *(const u32x4*)(vt_src + (j + 1) * 64); }
        const bf16* kb = Ks + buf * 64 * KS_PITCH; const bf16* vb = Vs + buf * 64 * VS_PITCH;
        f32x16 s0 = {}, s1 = {};
#pragma unroll
        for (int ks = 0; ks < 6; ++ks) { const bf16x8 a0 = *(const bf16x8*)(kb + r32 * KS_PITCH + 16 * ks + 8 * hi), a1 = *(const bf16x8*)(kb + (32 + r32) * KS_PITCH + 16 * ks + 8 * hi);
            s0 = __builtin_amdgcn_mfma_f32_32x32x16_bf16(a0, qf[ks], s0, 0, 0, 0); s1 = __builtin_amdgcn_mfma_f32_32x32x16_bf16(a1, qf[ks], s1, 0, 0, 0);
            if (ks & 1) asm volatile("" ::: "memory"); }
        float mx = s0[0];
#pragma unroll
        for (int r = 1; r < 16; ++r) mx = fmaxf(mx, s0[r]);
#pragma unroll
        for (int r = 0; r < 16; ++r) mx = fmaxf(mx, s1[r]);
        mx = fmaxf(mx, __shfl_xor(mx, 32));
        const float m_new = fmaxf(m_run, mx), alpha = __builtin_amdgcn_exp2f(m_run - m_new); m_run = m_new;
        float ps = 0.f;
#pragma unroll
        for (int r = 0; r < 16; ++r) { s0[r] = __builtin_amdgcn_exp2f(s0[r] - m_new); s1[r] = __builtin_amdgcn_exp2f(s1[r] - m_new); ps += s0[r] + s1[r]; }
        l_run = l_run * alpha + ps;
#pragma unroll
        for (int r = 0; r < 16; ++r) { const float ar = __shfl(alpha, crow(r, hi)); o0[r] *= ar; o1[r] *= ar; }
        bf16x8 pa[4];
#pragma unroll
        for (int s2 = 0; s2 < 2; ++s2) {
            u32x4 w0, w1;
            w0.x = pg8::cvt_pk_bf16(s0[8 * s2 + 0], s0[8 * s2 + 1]); w0.y = pg8::cvt_pk_bf16(s0[8 * s2 + 2], s0[8 * s2 + 3]); w0.z = pg8::cvt_pk_bf16(s0[8 * s2 + 4], s0[8 * s2 + 5]); w0.w = pg8::cvt_pk_bf16(s0[8 * s2 + 6], s0[8 * s2 + 7]);
            w1.x = pg8::cvt_pk_bf16(s1[8 * s2 + 0], s1[8 * s2 + 1]); w1.y = pg8::cvt_pk_bf16(s1[8 * s2 + 2], s1[8 * s2 + 3]); w1.z = pg8::cvt_pk_bf16(s1[8 * s2 + 4], s1[8 * s2 + 5]); w1.w = pg8::cvt_pk_bf16(s1[8 * s2 + 6], s1[8 * s2 + 7]);
            pa[s2] = __builtin_bit_cast(bf16x8, w0); pa[2 + s2] = __builtin_bit_cast(bf16x8, w1);
        }
#pragma unroll
        for (int kk = 0; kk < 4; ++kk) {
            const int base = 16 * kk + 4 * hi;
            const u32x2 l0 = *(const u32x2*)(vb + r32 * VS_PITCH + base), h0 = *(const u32x2*)(vb + r32 * VS_PITCH + base + 8);
            const u32x2 l1 = *(const u32x2*)(vb + (32 + r32) * VS_PITCH + base), h1 = *(const u32x2*)(vb + (32 + r32) * VS_PITCH + base + 8);
            const bf16x8 vf0 = __builtin_bit_cast(bf16x8, (u32x4){l0.x, l0.y, h0.x, h0.y}), vf1 = __builtin_bit_cast(bf16x8, (u32x4){l1.x, l1.y, h1.x, h1.y});
            o0 = __builtin_amdgcn_mfma_f32_32x32x16_bf16(pa[kk], vf0, o0, 0, 0, 0); o1 = __builtin_amdgcn_mfma_f32_32x32x16_bf16(pa[kk], vf1, o1, 0, 0, 0);
            if (kk & 1) asm volatile("" ::: "memory");
        }
        if (j + 1 < NT) { bf16* kd = Ks + (buf ^ 1) * 64 * KS_PITCH; bf16* vd2 = Vs + (buf ^ 1) * 64 * VS_PITCH;
            *(u32x4*)(kd + kkey * KS_PITCH + kch * 8) = kreg; if (tid < 256) *(u32x4*)(kd + rkey * KS_PITCH + 64 + rch * 8) = rreg;
            u32x2* vp = (u32x2*)(vd2 + vd * VS_PITCH + vch * 8); vp[0] = (u32x2){vreg.x, vreg.y}; vp[1] = (u32x2){vreg.z, vreg.w}; }
        __syncthreads();
    }
    const float lt = l_run + __shfl_xor(l_run, 32); const float inv = 1.0f / lt;
#pragma unroll
    for (int r = 0; r < 16; ++r) { const int q = crow(r, hi); const float ir = __shfl(inv, q);
        St[q * ATT_ST_PITCH + r32] = (bf16)f2bf(o0[r] * ir); St[q * ATT_ST_PITCH + 32 + r32] = (bf16)f2bf(o1[r] * ir); }
    __builtin_amdgcn_s_waitcnt(0xc07f); asm volatile("" ::: "memory");
#pragma unroll
    for (int it = 0; it < 4; ++it) { const int q = it * 8 + (lane >> 3), ch = lane & 7; const int row = qrow0 + wave * 32 + q;
        const u32x4 ov = *(const u32x4*)(St + q * ATT_ST_PITCH + ch * 8); const u32x4 gv = *(const u32x4*)(SGB + (size_t)row * 512 + h * 64 + ch * 8);
        u32x4 res;
#pragma unroll
        for (int e = 0; e < 4; ++e) { const unsigned ow = ov[e], gw = gv[e];
            res[e] = pk2(bf2f(ow & 0xffffu) * bf2f(gw & 0xffffu), bf2f(ow >> 16) * bf2f(gw >> 16)); }
        *(u32x4*)(Z + (size_t)row * DM + 512 + h * 64 + ch * 8) = res; }
    __builtin_amdgcn_s_waitcnt(0xc07f); asm volatile("" ::: "memory");
}
__device__ __forceinline__ void attn_phase(ArgsP a, unsigned char* lds, int tid, int lane, int wave, int vcu, int G) {
    for (int su = vcu; su < 512; su += G) { const int b = su >> 7, h = (su >> 4) & 7, qb = su & 15;
        attn_unit(a, lds, NPR + b * LSM + qb * 256, NPR + b * LKS, LKS, h, tid, lane, wave); }
    for (int pu = vcu; pu < 128; pu += G) { const int b = pu >> 3, h = pu & 7;
        attn_unit(a, lds, b * LPR, b * LPR, LPR, h, tid, lane, wave); }
}
__device__ __forceinline__ void transpose_yt_phase(ArgsP a, unsigned char* lds, int lane, int wave, int bid, int G) {
    const bf16* YT = (const bf16*)(a->ws + WS_YT); bf16* Z = (bf16*)(a->ws + WS_Z);
    bf16* scr = (bf16*)lds + wave * (64 * 66);
    const int gw = bid * NWAVES + wave, NGW = G * NWAVES;
    __syncthreads();
    for (int it = gw; it < 8 * 320; it += NGW) { const int c0 = (it & 7) * 64, t0 = (it >> 3) * 64;
#pragma unroll
        for (int i = 0; i < 8; ++i) { const int c = i * 8 + (lane >> 3), ch = lane & 7; const u32x4 v = *(const u32x4*)(YT + (size_t)(c0 + c) * NTOK + t0 + ch * 8);
#pragma unroll
            for (int e = 0; e < 4; ++e) { scr[(ch * 8 + 2 * e) * 66 + c] = (bf16)(v[e] & 0xffffu); scr[(ch * 8 + 2 * e + 1) * 66 + c] = (bf16)(v[e] >> 16); } }
        __builtin_amdgcn_s_waitcnt(0xc07f); asm volatile("" ::: "memory");
#pragma unroll
        for (int i = 0; i < 8; ++i) { const int t = i * 8 + (lane >> 3), ch = lane & 7; const unsigned* sp = (const unsigned*)(scr + t * 66 + ch * 8);
            u32x4 o; o.x = sp[0]; o.y = sp[1]; o.z = sp[2]; o.w = sp[3]; *(u32x4*)(Z + (size_t)(t0 + t) * DM + c0 + ch * 8) = o; }
        __builtin_amdgcn_s_waitcnt(0xc07f); asm volatile("" ::: "memory");
    }
}

__device__ __forceinline__ void dft_prompt_phase(ArgsP a, unsigned char* lds, int tid, int bid, int G) {
    const bf16* A = (const bf16*)(a->ws + WS_A); const bf16* B = (const bf16*)(a->ws + WS_B); const bf16* SG = (const bf16*)(a->ws + WS_SG); bf16* Z2 = (bf16*)(a->ws + WS_Z2);
    float* tw = (float*)lds; const float* TW = (const float*)(a->ws + WS_TW) + 2 * 4096;
    __syncthreads();
    for (int i = tid; i < 512; i += 512) tw[i] = TW[i];
    __syncthreads();
    for (int task = bid; task < 16 * 32; task += G) { const int b = task >> 5, l0 = (task & 31) * 8; float acc[8][2];
#pragma unroll
        for (int i = 0; i < 8; ++i) { acc[i][0] = 0.f; acc[i][1] = 0.f; }
        for (int l = 0; l < 256; ++l) { const size_t off = (size_t)(b * 256 + l) * DM + 2 * tid; const unsigned av = *(const unsigned*)(A + off), bv = *(const unsigned*)(B + off);
            const float a0 = bf2f(av & 0xffffu), a1 = bf2f(av >> 16), b0 = bf2f(bv & 0xffffu), b1 = bf2f(bv >> 16);
#pragma unroll
            for (int i = 0; i < 8; ++i) { const int m = (l * (l0 + i)) & 255; const float cs = tw[2 * m], sn = tw[2 * m + 1]; acc[i][0] += cs * a0 - sn * b0; acc[i][1] += cs * a1 - sn * b1; } }
#pragma unroll
        for (int i = 0; i < 8; ++i) { const size_t off = (size_t)(b * 256 + l0 + i) * DM + 2 * tid; const unsigned g = *(const unsigned*)(SG + off);
            *(unsigned*)(Z2 + off) = pk2(acc[i][0] * 0.0625f * bf2f(g & 0xffffu), acc[i][1] * 0.0625f * bf2f(g >> 16)); }
    }
}
__device__ __forceinline__ void dft_stage1_phase(ArgsP a, unsigned char* lds, int tid, int bid, int G) {
    const bf16* A = (const bf16*)(a->ws + WS_A); const bf16* B = (const bf16*)(a->ws + WS_B); bf16* TR = (bf16*)(a->ws + WS_TR); bf16* TI = (bf16*)(a->ws + WS_TI);
    float* tw64 = (float*)lds; const float* TW = (const float*)(a->ws + WS_TW);
    __syncthreads();
    if (tid < 128) tw64[tid] = TW[2 * (4096 + 256) + tid];
    __syncthreads();
    for (int task = bid; task < 4 * 64 * 8; task += G) { const int b = task >> 9, n2 = (task >> 3) & 63, k10 = (task & 7) * 8; float tr[8][2], ti[8][2];
#pragma unroll
        for (int i = 0; i < 8; ++i) { tr[i][0] = tr[i][1] = ti[i][0] = ti[i][1] = 0.f; }
        for (int n1 = 0; n1 < 64; ++n1) { const size_t off = (size_t)(NPR + b * LSM + 64 * n1 + n2) * DM + 2 * tid; const unsigned av = *(const unsigned*)(A + off), bv = *(const unsigned*)(B + off);
            const float a0 = bf2f(av & 0xffffu), a1 = bf2f(av >> 16), b0 = bf2f(bv & 0xffffu), b1 = bf2f(bv >> 16);
#pragma unroll
            for (int i = 0; i < 8; ++i) { const int m = (n1 * (k10 + i)) & 63; const float cr = tw64[2 * m], sn = tw64[2 * m + 1];
                tr[i][0] += cr * a0 - sn * b0; tr[i][1] += cr * a1 - sn * b1; ti[i][0] -= cr * b0 + sn * a0; ti[i][1] -= cr * b1 + sn * a1; } }
#pragma unroll
        for (int i = 0; i < 8; ++i) { const int k1 = k10 + i; const int m = n2 * k1; const float ct = TW[2 * m], st = TW[2 * m + 1];
            const size_t off = ((size_t)((b * 64 + k1) * 64 + n2)) * DM + 2 * tid;
            *(unsigned*)(TR + off) = pk2(tr[i][0] * ct + ti[i][0] * st, tr[i][1] * ct + ti[i][1] * st);
            *(unsigned*)(TI + off) = pk2(ti[i][0] * ct - tr[i][0] * st, ti[i][1] * ct - tr[i][1] * st); }
    }
}
__device__ __forceinline__ void dft_stage2_phase(ArgsP a, unsigned char* lds, int tid, int bid, int G) {
    const bf16* TR = (const bf16*)(a->ws + WS_TR); const bf16* TI = (const bf16*)(a->ws + WS_TI); const bf16* SG = (const bf16*)(a->ws + WS_SG); bf16* Z2 = (bf16*)(a->ws + WS_Z2);
    float* tw64 = (float*)lds; const float* TW = (const float*)(a->ws + WS_TW);
    __syncthreads();
    if (tid < 128) tw64[tid] = TW[2 * (4096 + 256) + tid];
    __syncthreads();
    for (int task = bid; task < 4 * 64 * 8; task += G) { const int b = task >> 9, k1 = (task >> 3) & 63, k20 = (task & 7) * 8; float acc[8][2];
#pragma unroll
        for (int i = 0; i < 8; ++i) { acc[i][0] = 0.f; acc[i][1] = 0.f; }
        for (int n2 = 0; n2 < 64; ++n2) { const size_t off = ((size_t)((b * 64 + k1) * 64 + n2)) * DM + 2 * tid; const unsigned rv = *(const unsigned*)(TR + off), iv = *(const unsigned*)(TI + off);
            const float r0 = bf2f(rv & 0xffffu), r1 = bf2f(rv >> 16), i0 = bf2f(iv & 0xffffu), i1 = bf2f(iv >> 16);
#pragma unroll
            for (int i = 0; i < 8; ++i) { const int m = (n2 * (k20 + i)) & 63; const float c2 = tw64[2 * m], s2 = tw64[2 * m + 1]; acc[i][0] += r0 * c2 + i0 * s2; acc[i][1] += r1 * c2 + i1 * s2; } }
#pragma unroll
        for (int i = 0; i < 8; ++i) { const size_t off = (size_t)(NPR + b * LSM + k1 + 64 * (k20 + i)) * DM + 2 * tid; const unsigned g = *(const unsigned*)(SG + off);
            *(unsigned*)(Z2 + off) = pk2(acc[i][0] * 0.015625f * bf2f(g & 0xffffu), acc[i][1] * 0.015625f * bf2f(g >> 16)); }
    }
}

constexpr int NPHASE = 12;
#define PH_CTX const Ctx cx_ = get_ctx(); ArgsP A = cx_.a; const int G = A->grid, bid = cx_.bid; const int wave = cx_.wave, lane = LANE_ID(), tid = wave * 64 + lane; (void)tid; \
    unsigned char* const ws = A->ws; (void)G; (void)bid; (void)lane; (void)wave; (void)ws
__device__ __forceinline__ bool ph_in(int k) { const Ctx cx_ = get_ctx(); return cx_.a->ph_lo <= k && k < cx_.a->ph_hi; }
__device__ __forceinline__ void ph_seam(int k, unsigned char* lds) {
    const Ctx cx_ = get_ctx(); ArgsP A = cx_.a; const int wave_s = cx_.wave;
    if (A->ph_lo <= k && k + 1 < A->ph_hi) { XcdBarrier bar; bar.bar = (unsigned*)((gu32*)(A->ws + WS_CTL) + CW_BAR); bar.x = xb_xcc_id(); bar.st = (volatile LAS unsigned*)((LAS unsigned char*)lds + MISC_OFF) + 8; xcd_barrier(bar, wave_s == 0 && __builtin_amdgcn_mbcnt_hi(~0u, __builtin_amdgcn_mbcnt_lo(~0u, 0u)) == 0u); }
}
__global__ void __launch_bounds__(NWAVES * 64, 2) fwd_kernel(Args args_unused_directly) {
    unsigned char* const lds = g_lds;
    {
        const int wave0 = __builtin_amdgcn_readfirstlane((int)threadIdx.x >> 6), lane0 = LANE_ID(), tid0 = wave0 * 64 + lane0;
        LAS unsigned* cw = (LAS unsigned*)((LAS unsigned char*)lds + LDSCTL_OFF);
        for (int u = tid0; u < (LDS_BYTES - LDSCTL_OFF) / 4; u += NWAVES * 64) cw[u] = 0u;
        __syncthreads();
        const unsigned long long kp = (unsigned long long)(uintptr_t)__builtin_amdgcn_kernarg_segment_ptr();
        if (lane0 == 0) cw[hw_slot()] = (unsigned)wave0;
        if (tid0 == 0) { cw[64] = blockIdx.x; cw[66] = (unsigned)kp; cw[67] = (unsigned)(kp >> 32); }
        __syncthreads();
        ArgsP A = (ArgsP)__builtin_amdgcn_kernarg_segment_ptr();
        if (cw[hw_slot()] != (unsigned)wave0 && lane0 == 0) A->out[0] = __builtin_nanf("");
        if (A->ph_hi - A->ph_lo > 1) (void)xcd_barrier_post((unsigned*)((gu32*)(A->ws + WS_CTL) + CW_BAR), (volatile LAS unsigned*)((LAS unsigned char*)lds + MISC_OFF) + 8, tid0 == 0);
    }
#ifndef PH_MASK
#define PH_MASK 0xFFF
#endif
#define IN(k) ((((PH_MASK) >> (k)) & 1) && ph_in(k))
#define SEAM(k) ph_seam(k, lds)
#define BF(off) ((pg8::bf16_t*)(ws + (off)))
#define RING ((PG8_LAS unsigned char*)lds)

    if (IN(0)) { phase0(lds); }
    SEAM(0);
    if (IN(1)) { PH_CTX; norm_mod_phase(A, 0, lane, wave, bid, G); fnet_fold_phase(A, lds, tid, bid, G); }
    SEAM(1);
    if (IN(2)) {
        { PH_CTX; pg8::Gemm g{BF(WS_WT_IN_E), BF(WS_H), 2048, NTOK, 1024}; pg8::StaticOrder S; S.init(2048, NTOK, G, bid);
          pg8::EpiP2a E{ws};
          pg8::gemm_phase<pg8::EpiP2a, pg8::StaticOrder, true, true>(RING, g, S, E, wave); }
        { PH_CTX; pg8::Gemm g{BF(WS_H), BF(WS_WT_IN_E) + (size_t)2048 * 1024, NTOK, 1280, 1024}; pg8::StaticOrder S; S.init(NTOK, 1280, G, bid);
          pg8::EpiP2b E{ws, A->out, A->in[I_QG], A->in[I_KVG]};
          pg8::gemm_phase<pg8::EpiP2b, pg8::StaticOrder, true, true>(RING, g, S, E, wave); }
    }
    SEAM(2);
    if (IN(3)) {
#ifndef NO_P3Q
        { PH_CTX; int K3 = 256; asm volatile("" : "+s"(K3));
          pg8::Gemm g{BF(WS_CQ), BF(WS_WT_UQ), NTOK, 768, K3}; pg8::StaticOrder S; S.init(NTOK, 768, G, bid);
          pg8::EpiP3q E{ws};
          pg8::gemm_phase<pg8::EpiP3q, pg8::StaticOrder, true, true>(RING, g, S, E, wave); }
#endif
#ifndef NO_P3K
        { PH_CTX; int K3 = 256; asm volatile("" : "+s"(K3));
          pg8::Gemm g{BF(WS_CKV), BF(WS_WT_UK), NKV, 512, K3}; pg8::StaticOrder S; S.init(NKV, 512, G, bid);
          pg8::EpiP3k E{ws};
          pg8::gemm_phase<pg8::EpiP3k, pg8::StaticOrder, true, true>(RING, g, S, E, wave); }
#endif
#ifndef NO_P3V
        { PH_CTX; int K3 = 256; asm volatile("" : "+s"(K3));
          pg8::Gemm g{BF(WS_WT_UV), BF(WS_CKV), 512, NKV, K3}; pg8::StaticOrder S; S.init(512, NKV, G, bid);
          pg8::EpiP3v E{ws};
          pg8::gemm_phase<pg8::EpiP3v, pg8::StaticOrder, true, true>(RING, g, S, E, wave); }
#endif
        { PH_CTX; state_fix_phase(A, tid, bid, G);
#ifndef NO_HYENA
          for (int u = bid; u < 1024; u += G) { if (u < 512) hyena_unit<true>(A, lds, u, tid, lane, wave); else hyena_unit<false>(A, lds, u - 512, tid, lane, wave); }
#endif
          __syncthreads(); }
    }
    SEAM(3);
    if (IN(4)) { PH_CTX; const int vcu = (G % 8 == 0) ? (bid % 8) * (G / 8) + bid / 8 : bid;
#ifndef NO_ATTN
        attn_phase(A, lds, tid, lane, wave, vcu, G);
#endif
#ifndef NO_TRANSP
        transpose_yt_phase(A, lds, lane, wave, bid, G);
#endif
        __syncthreads(); }
    SEAM(4);
    if (IN(5)) { PH_CTX;
        pg8::Gemm g{BF(WS_Z), BF(WS_WT_OUT_E), NTOK, 1024, 1024}; pg8::StaticOrder S; S.init(NTOK, 1024, G, bid);
        pg8::EpiRes E{A->in[I_XP], A->in[I_XS], A->out, (const float*)(ws + WS_MOD) + 2048};
        pg8::gemm_phase<pg8::EpiRes, pg8::StaticOrder, true, true>(RING, g, S, E, wave);
    }
    SEAM(5);
    if (IN(6)) { PH_CTX; norm_mod_phase(A, 1, lane, wave, bid, G); }
    SEAM(6);
    if (IN(7)) { PH_CTX;
        pg8::Gemm g{BF(WS_H), BF(WS_WT_IN_O), NTOK, 3072, 1024}; pg8::StaticOrder S; S.init(NTOK, 3072, G, bid);
        pg8::EpiP7 E{ws};
        pg8::gemm_phase<pg8::EpiP7, pg8::StaticOrder, true, true>(RING, g, S, E, wave);
    }
    SEAM(7);
    if (IN(8)) { PH_CTX; dft_stage1_phase(A, lds, tid, bid, G); dft_prompt_phase(A, lds, tid, bid, G); __syncthreads(); }
    SEAM(8);
    if (IN(9)) { PH_CTX; dft_stage2_phase(A, lds, tid, bid, G); __syncthreads(); }
    SEAM(9);
    if (IN(10)) { PH_CTX; float* outp = A->out;
        pg8::Gemm g{BF(WS_Z2), BF(WS_WT_OUT_O), NTOK, 1024, 1024}; pg8::StaticOrder S; S.init(NTOK, 1024, G, bid);
        pg8::EpiRes E{outp, outp + (size_t)NPR * DM, outp, (const float*)(ws + WS_MOD) + 5 * 3072 + 2048};
        pg8::gemm_phase<pg8::EpiRes, pg8::StaticOrder, true, true>(RING, g, S, E, wave);
    }
    SEAM(10);
    if (IN(11)) { PH_CTX; final_norm_phase(A, lane, wave, bid, G); }
#undef IN
#undef SEAM
#undef BF
#undef RING
}

extern "C" void kernel_launch(void* const* d_in, const int* in_sizes, int n_in, void* d_out, int out_size, void* d_ws, size_t ws_size, hipStream_t stream) {
    static int grid = 0;
    if (grid == 0) {
        if (n_in != 27 || out_size != NTOK * DM + NPR * 256 + NPR * 32 || ws_size < WS_END) { fprintf(stderr, "kernel_launch: unexpected shapes (n_in %d out %d ws %zu)\n", n_in, out_size, ws_size); grid = -1; return; }
        int dev = 0, cus = 0, per_cu = 0;
        if (hipGetDevice(&dev) != hipSuccess || hipDeviceGetAttribute(&cus, hipDeviceAttributeMultiprocessorCount, dev) != hipSuccess) { grid = -1; return; }
        if (hipFuncSetAttribute((const void*)fwd_kernel, hipFuncAttributeMaxDynamicSharedMemorySize, LDS_BYTES) != hipSuccess) { fprintf(stderr, "kernel_launch: hipFuncSetAttribute failed\n"); grid = -1; return; }
        if (hipOccupancyMaxActiveBlocksPerMultiprocessor(&per_cu, (const void*)fwd_kernel, NWAVES * 64, LDS_BYTES) != hipSuccess || per_cu < 1) { fprintf(stderr, "kernel_launch: occupancy query says %d blocks per CU\n", per_cu); per_cu = 1; }
        (void)hipGetLastError();
        grid = cus;
    }
    if (grid < 0) return;
    (void)hipMemsetAsync((char*)d_ws + WS_CTL, 0, CTL_ZERO_BYTES, stream);
    Args a{};
    for (int i = 0; i < 27; ++i) a.in[i] = (const float*)d_in[i];
    a.out = (float*)d_out; a.ws = (unsigned char*)d_ws; a.grid = grid; a.pad = 0;
#if MK_N_LAUNCHES == 1
    a.ph_lo = 0; a.ph_hi = NPHASE;
    hipLaunchKernelGGL(fwd_kernel, dim3(grid), dim3(NWAVES * 64), LDS_BYTES, stream, a);
#else
    for (int p = 0; p < NPHASE; ++p) { a.ph_lo = p; a.ph_hi = p + 1; hipLaunchKernelGGL(fwd_kernel, dim3(grid), dim3(NWAVES * 64), LDS_BYTES, stream, a); }
#endif
}
```

```cpp
#include <hip/hip_runtime.h>
#include <cstdio>
#include <cstdint>

#ifndef MK_N_LAUNCHES
#define MK_N_LAUNCHES 1
#endif

constexpr int DM = 1024;
constexpr int NPR = 4096;
constexpr int NSM = 16384;
constexpr int NTOK = NPR + NSM;
constexpr int LPR = 256, LSM = 4096, PAST = 512, LKS = PAST + LSM;
constexpr int NKV = NPR + 4 * LKS;
constexpr int DA = 512, NH = 8, QKD = 96, NOPE = 64, ROPED = 32, VD = 64;
constexpr float EPS = 1e-6f;
constexpr float ATTN_SCALE_LOG2E = 0.10206207261596575f * 1.4426950408889634f;

constexpr size_t MiB = 1u << 20, KiB = 1u << 10;
constexpr size_t WS_CTL = 0, CTL_ZERO_BYTES = 128 * KiB;
constexpr size_t WS_MOD = 1 * MiB;
constexpr size_t WS_ROPE = 1 * MiB + 128 * KiB;
constexpr size_t WS_SSQQ = 1 * MiB + 256 * KiB;
constexpr size_t WS_SSQKV = 1 * MiB + 576 * KiB;
constexpr size_t WS_PQ = 2 * MiB;
constexpr size_t WS_PS = 3 * MiB;
constexpr size_t WS_TW = 5 * MiB;
constexpr size_t WS_WT_IN_E = 6 * MiB;
constexpr size_t WS_WT_UQ = 12 * MiB + 512 * KiB;
constexpr size_t WS_WT_UK = 12 * MiB + 896 * KiB;
constexpr size_t WS_WT_UV = 13 * MiB + 128 * KiB;
constexpr size_t WS_WT_OUT_E = 13 * MiB + 512 * KiB;
constexpr size_t WS_WT_IN_O = 15 * MiB + 512 * KiB;
constexpr size_t WS_WT_OUT_O = 21 * MiB + 512 * KiB;
constexpr size_t WS_KF0 = 24 * MiB;
constexpr size_t WS_KF1 = 32 * MiB;
constexpr size_t WS_H = 36 * MiB;
constexpr size_t WS_VT = 36 * MiB;
constexpr size_t WS_YT = 58 * MiB;
constexpr size_t WS_UT = 78 * MiB;
constexpr size_t WS_Z = 78 * MiB;
constexpr size_t WS_A = 78 * MiB, WS_B = 118 * MiB, WS_SG = 158 * MiB;
constexpr size_t WS_CQ = 158 * MiB;
constexpr size_t WS_CKV = 168 * MiB;
constexpr size_t WS_KR = 179 * MiB;
constexpr size_t WS_SGB = 181 * MiB;
constexpr size_t WS_Q = 201 * MiB;
constexpr size_t WS_KN = 231 * MiB;
constexpr size_t WS_TR = 198 * MiB, WS_TI = 36 * MiB;
constexpr size_t WS_Z2 = 70 * MiB;
constexpr size_t WS_X1B0 = 24 * MiB, WS_X1B1 = 230 * MiB;
constexpr size_t WS_X2B = 110 * MiB;
constexpr size_t WS_END = 254 * MiB;

typedef unsigned short bf16;
typedef float f32x4 __attribute__((ext_vector_type(4)));
typedef float f32x16 __attribute__((ext_vector_type(16)));
typedef unsigned u32x4 __attribute__((ext_vector_type(4)));
typedef unsigned u32x2 __attribute__((ext_vector_type(2)));
typedef short bf16x8 __attribute__((ext_vector_type(8)));

__device__ __forceinline__ unsigned f2bf(float f) { unsigned u = __float_as_uint(f); return (u + 0x7fffu + ((u >> 16) & 1u)) >> 16; }
__device__ __forceinline__ float bf2f(unsigned h) { return __uint_as_float(h << 16); }
__device__ __forceinline__ unsigned pk2(float lo, float hi) { return f2bf(lo) | (f2bf(hi) << 16); }
__device__ __forceinline__ float siluf(float x) { return x * __builtin_amdgcn_rcpf(1.0f + __expf(-x)); }
__device__ __forceinline__ int kvrow_of(int r) { if (r < NPR) return r; const int s = r - NPR; return NPR + (s >> 12) * LKS + PAST + (s & 4095); }
__device__ __forceinline__ bf16* x1b_tile(unsigned char* ws, float* out, int pm) {
    if (pm < 16) return (bf16*)((unsigned char*)out + 16 * MiB) + (size_t)pm * (256 * DM);
    const int s = pm - 16; return (bf16*)(ws + (s < 16 ? WS_X1B0 + (size_t)s * (512 * KiB) : WS_X1B1 + (size_t)(s - 16) * (512 * KiB)));
}
__device__ __forceinline__ void unpack8(const u32x4 w, f32x4& a, f32x4& b) {
    a[0] = __uint_as_float(w.x << 16); a[1] = __uint_as_float(w.x & 0xffff0000u); a[2] = __uint_as_float(w.y << 16); a[3] = __uint_as_float(w.y & 0xffff0000u);
    b[0] = __uint_as_float(w.z << 16); b[1] = __uint_as_float(w.z & 0xffff0000u); b[2] = __uint_as_float(w.w << 16); b[3] = __uint_as_float(w.w & 0xffff0000u);
}

namespace pg8 {
#define PG8_LAS __attribute__((address_space(3)))
typedef unsigned short bf16_t;
typedef short bf16x8 __attribute__((ext_vector_type(8)));
typedef float f32x4 __attribute__((ext_vector_type(4)));
typedef unsigned u32x4 __attribute__((ext_vector_type(4)));
constexpr int BM = 256, BK = 64, HALF = 128, HTB = HALF * BK * 2  , STAGE_BYTES = 8 * HTB, NXCD = 8, WGM = 8;

__host__ __device__ __forceinline__ int lds_byte(int r, int c) { const int st = (r >> 4) * 2 + (c >> 5), rr = r & 15, cc = c & 31, ob = rr * 64 + cc * 2; return st * 1024 + (ob ^ (((ob >> 9) & 1) << 5)); }
__host__ __device__ __forceinline__ void stage_rc(int b, int& R, int& C) { const int st = b / 1024, sb = b % 1024, swz = sb ^ (((sb >> 9) & 1) << 5); R = (st >> 1) * 16 + swz / 64; C = (st & 1) * 32 + (swz % 64) / 2; }
__host__ __device__ __forceinline__ int perm32(int rho) { const int n = rho >> 4, i = rho & 15; return 8 * (i >> 2) + 4 * n + (i & 3); }

struct Unit { int pm, pn, w; };
struct Gemm { const bf16_t* A; const bf16_t* Bt; int M, N, K; const bf16_t* A2 = nullptr; const bf16_t* Bt2 = nullptr; };

struct StaticOrder {
    int nM, nN, nwg, G, c;
    __host__ __device__ void init(int M, int N, int G_, int c_) { nM = M / BM; nN = N / BM; nwg = nM * nN; G = G_; c = c_; }
    __host__ __device__ bool next(int i, Unit& u) const {
        const long L = (long)i * G + c; if (L >= nwg) return false;
        int wgid = (int)L; { const int q = nwg / NXCD, r = nwg % NXCD, xcd = wgid % NXCD, off = wgid / NXCD; wgid = (xcd < r ? xcd * (q + 1) : r * (q + 1) + (xcd - r) * q) + off; }
        const int nig = WGM * nN, gid = wgid / nig, fm = gid * WGM, gsz = (nM - fm) < WGM ? (nM - fm) : WGM;
        u.pm = fm + ((wgid % nig) % gsz); u.pn = (wgid % nig) / gsz; u.w = 0; return true;
    }
    __device__ __forceinline__ void a_ready(const Unit&) const {}
    __device__ __forceinline__ void done(const Unit&) const {}
};

typedef float f32x2_t __attribute__((ext_vector_type(2))); typedef __bf16 bf16x2_t __attribute__((ext_vector_type(2)));
__device__ __forceinline__ unsigned cvt_pk_bf16(float lo, float hi) { f32x2_t v = {lo, hi}; bf16x2_t b = __builtin_convertvector(v, bf16x2_t); return __builtin_bit_cast(unsigned, b); }
__device__ __forceinline__ u32x4 pack8(const f32x4 a, const f32x4 b) { u32x4 w; w.x = cvt_pk_bf16(a[0], a[1]); w.y = cvt_pk_bf16(a[2], a[3]); w.z = cvt_pk_bf16(b[0], b[1]); w.w = cvt_pk_bf16(b[2], b[3]); return w; }
__device__ __forceinline__ f32x4 silu4(f32x4 v) { f32x4 o; o[0] = siluf(v[0]); o[1] = siluf(v[1]); o[2] = siluf(v[2]); o[3] = siluf(v[3]); return o; }
__device__ __forceinline__ f32x4 shfl16_4(f32x4 v) { f32x4 o; o[0] = __shfl_xor(v[0], 16); o[1] = __shfl_xor(v[1], 16); o[2] = __shfl_xor(v[2], 16); o[3] = __shfl_xor(v[3], 16); return o; }
__device__ __forceinline__ void rope4(f32x4& v, int fq, const float* __restrict__ tb) {
    const f32x4 p = shfl16_4(v); const f32x4 t0 = *(const f32x4*)tb, t1 = *(const f32x4*)(tb + 4);
    const float c[4] = {t0[0], t0[2], t1[0], t1[2]}, s[4] = {t0[1], t0[3], t1[1], t1[3]};
    const float sg = (fq & 1) ? 1.0f : -1.0f;
#pragma unroll
    for (int e = 0; e < 4; ++e) v[e] = v[e] * c[e] + sg * (p[e] * s[e]);
}
__device__ __forceinline__ void rope8(f32x4& v0, f32x4& v1, int fq, int t, const float* __restrict__ rope) {
    const int pos = (fq >> 1) ? (t & 63) : (t >> 6);
    rope4(v0, fq, rope + pos * 16); asm volatile("" ::: "memory"); rope4(v1, fq, rope + pos * 16 + 8);
}

struct EpiP2a {
    static constexpr bool PERM = true, AFTER_DRAIN = false;
    unsigned char* ws;
    __device__ __forceinline__ void operator()(const f32x4 (&acc)[2][2][4][2], const Unit& u, int wr, int wc, int fr, int fq) const {
        asm volatile("" : "+v"(fr), "+v"(fq));
        const int row0 = u.pm * BM + wr * 64 + fr, col0 = u.pn * BM + wc * 32 + 8 * fq; const bool act = u.pm >= 6; bf16_t* const UT = (bf16_t*)(ws + WS_UT);
#pragma unroll
        for (int ai = 0; ai < 2; ++ai)
#pragma unroll
            for (int m = 0; m < 4; ++m) { bf16_t* rowp = UT + (size_t)(row0 + ai * HALF + m * 16) * NTOK + col0;
#pragma unroll
                for (int bj = 0; bj < 2; ++bj) { f32x4 v0 = acc[ai][bj][m][0], v1 = acc[ai][bj][m][1]; if (act) { v0 = silu4(v0); v1 = silu4(v1); }
                    *(u32x4*)(rowp + bj * HALF) = pack8(v0, v1); } }
    }
};
struct EpiP2b {
    static constexpr bool PERM = true, AFTER_DRAIN = false;
    unsigned char* ws; float* out; const float *qg, *kvg;
    __device__ __forceinline__ void operator()(const f32x4 (&acc)[2][2][4][2], const Unit& u, int wr, int wc, int fr, int fq) const {
        asm volatile("" : "+v"(fr), "+v"(fq));
        const int rowt = u.pm * BM; const bool samp = u.pm >= 16;
        const int kvb = samp ? (NPR + ((u.pm - 16) >> 4) * LKS + PAST + ((u.pm - 16) & 15) * BM) : rowt;
        const int rl0 = wr * 64 + fr, cl0 = wc * 32 + 8 * fq;
        bf16_t* const CQ = (bf16_t*)(ws + WS_CQ); bf16_t* const CKV = (bf16_t*)(ws + WS_CKV); bf16_t* const SGB = (bf16_t*)(ws + WS_SGB); bf16_t* const KR = (bf16_t*)(ws + WS_KR);
        float* const SSQQ = (float*)(ws + WS_SSQQ); float* const SSQKV = (float*)(ws + WS_SSQKV); const float* const rope = (const float*)(ws + WS_ROPE);
        float* const st_ckv = out + (size_t)NTOK * DM; float* const st_krope = st_ckv + (size_t)NPR * 256;
        if (u.pn <= 1) {
            const bool isq = (u.pn == 0);
            const float* gv = isq ? qg : kvg; bf16_t* dst = isq ? CQ : CKV; float* ssq = isq ? SSQQ : SSQKV; const int rb = isq ? rowt : kvb;
            f32x4 g[2][2];
#pragma unroll
            for (int bj = 0; bj < 2; ++bj) { g[bj][0] = *(const f32x4*)(gv + bj * HALF + cl0); g[bj][1] = *(const f32x4*)(gv + bj * HALF + cl0 + 4); }
#pragma unroll
            for (int ai = 0; ai < 2; ++ai)
#pragma unroll
                for (int m = 0; m < 4; ++m) { const int rl = rl0 + ai * HALF + m * 16;
                    float s = 0.f;
#pragma unroll
                    for (int bj = 0; bj < 2; ++bj)
#pragma unroll
                        for (int n = 0; n < 2; ++n) { const f32x4 x = acc[ai][bj][m][n]; s += (x[0] * x[0] + x[1] * x[1]) + (x[2] * x[2] + x[3] * x[3]); }
                    s += __shfl_xor(s, 16); s += __shfl_xor(s, 32);
                    if (fq == 0) ssq[(size_t)(rb + rl) * 4 + wc] = s;
#pragma unroll
                    for (int bj = 0; bj < 2; ++bj) { const f32x4 v0 = acc[ai][bj][m][0] * g[bj][0], v1 = acc[ai][bj][m][1] * g[bj][1];
                        *(u32x4*)(dst + (size_t)(rb + rl) * 256 + bj * HALF + cl0) = pack8(v0, v1);
                        if (!isq && !samp) { float* sp = st_ckv + (size_t)(rowt + rl) * 256 + bj * HALF + cl0; *(f32x4*)sp = v0; *(f32x4*)(sp + 4) = v1; } } }
        } else {
            const int cb = (u.pn - 2) * BM + cl0;
#pragma unroll
            for (int ai = 0; ai < 2; ++ai)
#pragma unroll
                for (int m = 0; m < 4; ++m) { bf16_t* rowp = SGB + (size_t)(rowt + rl0 + ai * HALF + m * 16) * 512 + cb;
#pragma unroll
                    for (int bj = 0; bj < 2; ++bj) *(u32x4*)(rowp + bj * HALF) = pack8(silu4(acc[ai][bj][m][0]), silu4(acc[ai][bj][m][1])); }
        }
    }
};
struct CountingOrder : StaticOrder {
    unsigned* pc;
    __device__ __forceinline__ void done(const Unit& u) const {
        asm volatile("s_waitcnt vmcnt(0)" ::: "memory");
        if (__builtin_amdgcn_mbcnt_hi(~0u, __builtin_amdgcn_mbcnt_lo(~0u, 0u)) == 0u) __hip_atomic_fetch_add(pc + 64 * u.pm, 1u, __ATOMIC_RELAXED, __HIP_MEMORY_SCOPE_AGENT);
    }
};
struct OffsetOrder : CountingOrder {
    int pm0;
    __device__ bool next(int i, Unit& u) const { if (!StaticOrder::next(i, u)) return false; u.pm += pm0; return true; }
};
struct OffsetPlain : StaticOrder {
    int pm0;
    __device__ bool next(int i, Unit& u) const { if (!StaticOrder::next(i, u)) return false; u.pm += pm0; return true; }
};
struct P5Order {
    unsigned* pc; int c;
    __device__ bool next(int i, Unit& u) const { const int x = c & 7, j = c >> 3; u.w = 0;
        if (i == 0) { u.pm = x * 8 + (j & 7); u.pn = j >> 3; return true; }
        if (i == 1 && c < 64) { u.pm = 64 + x * 2 + (j & 1); u.pn = j >> 1; return true; }
        return false; }
    __device__ __forceinline__ void a_ready(const Unit&) const {}
    __device__ __forceinline__ void done(const Unit& u) const {
        asm volatile("s_waitcnt vmcnt(0)" ::: "memory");
        if (__builtin_amdgcn_mbcnt_hi(~0u, __builtin_amdgcn_mbcnt_lo(~0u, 0u)) == 0u) __hip_atomic_fetch_add(pc + 64 * u.pm, 1u, __ATOMIC_RELAXED, __HIP_MEMORY_SCOPE_AGENT);
    }
};
struct P7GateOrder {
    unsigned* pr; unsigned* tmo; int c;
    __device__ bool next(int i, Unit& u) const { if (i) return false; const int x = c & 7, j = (c - 64) >> 3; u.pm = 2 * x + (j & 1); u.pn = j >> 1; u.w = 0; return true; }
    __device__ __forceinline__ void a_ready(const Unit& u) const { unsigned spins = 0;
        while ((unsigned)__builtin_amdgcn_readfirstlane((int)__hip_atomic_load(pr + 64 * u.pm, __ATOMIC_RELAXED, __HIP_MEMORY_SCOPE_AGENT)) < 32u) {
            __builtin_amdgcn_s_sleep(2);
            if (++spins > (1u << 22)) { __hip_atomic_store(tmo, 1u, __ATOMIC_RELAXED, __HIP_MEMORY_SCOPE_AGENT); break; } }
        __builtin_amdgcn_fence(__ATOMIC_ACQUIRE, "agent");
        asm volatile("s_waitcnt vmcnt(0)" ::: "memory"); }
    __device__ __forceinline__ void done(const Unit&) const {}
};
struct TwoOrder {
    StaticOrder s0, s1; int n0, n1, G, c;
    __device__ void init(int M0, int N0, int M1, int N1, int G_, int c_) { s0.init(M0, N0, 1, 0); s1.init(M1, N1, 1, 0); n0 = s0.nwg; n1 = s1.nwg; G = G_; c = c_; }
    __device__ bool next(int i, Unit& u) const { const int L = i * G + c; if (L >= n0 + n1) return false; if (L < n0) { s0.next(L, u); u.w = 0; } else { s1.next(L - n0, u); u.w = 1; } return true; }
    __device__ __forceinline__ void a_ready(const Unit&) const {}
    __device__ __forceinline__ void done(const Unit&) const {}
};
struct EpiP2 {
    static constexpr bool PERM = true, AFTER_DRAIN = false;
    EpiP2a ea; EpiP2b eb;
    __device__ __forceinline__ void operator()(const f32x4 (&acc)[2][2][4][2], const Unit& u, int wr, int wc, int fr, int fq) const { if (u.w == 0) ea(acc, u, wr, wc, fr, fq); else eb(acc, u, wr, wc, fr, fq); }
};
struct EpiP3q {
    static constexpr bool PERM = true, AFTER_DRAIN = false;
    unsigned char* ws;
    __device__ __forceinline__ void operator()(const f32x4 (&acc)[2][2][4][2], const Unit& u, int wr, int wc, int fr, int fq) const {
        asm volatile("" : "+v"(fr), "+v"(fq));
        const int rowt = u.pm * BM; const bool samp = u.pm >= 16; const int rl0 = wr * 64 + fr, cl0 = u.pn * BM + wc * 32 + 8 * fq;
        bf16_t* const Q = (bf16_t*)(ws + WS_Q); const float* const SSQQ = (const float*)(ws + WS_SSQQ); const float* const rope = (const float*)(ws + WS_ROPE); constexpr float scale = ATTN_SCALE_LOG2E;
#pragma unroll
        for (int ai = 0; ai < 2; ++ai)
#pragma unroll
            for (int m = 0; m < 4; ++m) { const int rl = rl0 + ai * HALF + m * 16; const f32x4 s4 = *(const f32x4*)(SSQQ + (size_t)(rowt + rl) * 4);
                const float rs = __builtin_amdgcn_rsqf(((s4[0] + s4[1]) + (s4[2] + s4[3])) * (1.0f / 256.0f) + EPS) * scale;
#pragma unroll
                for (int bj = 0; bj < 2; ++bj) { f32x4 v0 = acc[ai][bj][m][0] * rs, v1 = acc[ai][bj][m][1] * rs;
                    const int g32 = u.pn * 8 + bj * 4 + wc;
                    if (samp && (g32 % 3) == 2) rope8(v0, v1, fq, ((u.pm - 16) & 15) * BM + rl, rope);
                    *(u32x4*)(Q + (size_t)(rowt + rl) * 768 + bj * HALF + cl0) = pack8(v0, v1); }
                asm volatile("" ::: "memory"); }
    }
};
struct EpiP3k {
    static constexpr bool PERM = true, AFTER_DRAIN = false;
    unsigned char* ws;
    __device__ __forceinline__ void operator()(const f32x4 (&acc)[2][2][4][2], const Unit& u, int wr, int wc, int fr, int fq) const {
        asm volatile("" : "+v"(fr), "+v"(fq));
        bf16_t* const KN = (bf16_t*)(ws + WS_KN); const float* const SSQKV = (const float*)(ws + WS_SSQKV);
        const int rowt = u.pm * BM; const bool cache = (u.pm >= 16) && (((u.pm - 16) % 18) < 2); const int rl0 = wr * 64 + fr, cl0 = u.pn * BM + wc * 32 + 8 * fq;
#pragma unroll
        for (int ai = 0; ai < 2; ++ai)
#pragma unroll
            for (int m = 0; m < 4; ++m) { const int rl = rl0 + ai * HALF + m * 16; float rs = 1.0f;
                if (!cache) { const f32x4 s4 = *(const f32x4*)(SSQKV + (size_t)(rowt + rl) * 4); rs = __builtin_amdgcn_rsqf(((s4[0] + s4[1]) + (s4[2] + s4[3])) * (1.0f / 256.0f) + EPS); }
#pragma unroll
                for (int bj = 0; bj < 2; ++bj) *(u32x4*)(KN + (size_t)(rowt + rl) * 512 + bj * HALF + cl0) = pack8(acc[ai][bj][m][0] * rs, acc[ai][bj][m][1] * rs);
                asm volatile("" ::: "memory"); }
    }
};
struct EpiP3v {
    static constexpr bool PERM = true, AFTER_DRAIN = false;
    unsigned char* ws;
    __device__ __forceinline__ void operator()(const f32x4 (&acc)[2][2][4][2], const Unit& u, int wr, int wc, int fr, int fq) const {
        asm volatile("" : "+v"(fr), "+v"(fq));
        bf16_t* const VT = (bf16_t*)(ws + WS_VT); const float* const SSQKV = (const float*)(ws + WS_SSQKV);
        const bool cache = (u.pn >= 16) && (((u.pn - 16) % 18) < 2); const int row0 = u.pm * BM + wr * 64 + fr, col0 = u.pn * BM + wc * 32 + 8 * fq;
#pragma unroll
        for (int bj = 0; bj < 2; ++bj) { f32x4 r0 = {1.f, 1.f, 1.f, 1.f}, r1 = {1.f, 1.f, 1.f, 1.f};
            if (!cache) {
#pragma unroll
                for (int e = 0; e < 4; ++e) { const f32x4 a = *(const f32x4*)(SSQKV + (size_t)(col0 + bj * HALF + e) * 4), b = *(const f32x4*)(SSQKV + (size_t)(col0 + bj * HALF + 4 + e) * 4);
                    r0[e] = __builtin_amdgcn_rsqf(((a[0] + a[1]) + (a[2] + a[3])) * (1.0f / 256.0f) + EPS); r1[e] = __builtin_amdgcn_rsqf(((b[0] + b[1]) + (b[2] + b[3])) * (1.0f / 256.0f) + EPS);
                    asm volatile("" ::: "memory"); } }
#pragma unroll
            for (int ai = 0; ai < 2; ++ai)
#pragma unroll
                for (int m = 0; m < 4; ++m) *(u32x4*)(VT + (size_t)(row0 + ai * HALF + m * 16) * NKV + col0 + bj * HALF) = pack8(acc[ai][bj][m][0] * r0, acc[ai][bj][m][1] * r1); }
    }
};
template <int LAYER>
struct EpiResB {
    static constexpr bool PERM = true, AFTER_DRAIN = false;
    const float* xp; const float* xs; float* out; unsigned char* ws;
    __device__ __forceinline__ void operator()(const f32x4 (&acc)[2][2][4][2], const Unit& u, int wr, int wc, int fr, int fq) const {
        asm volatile("" : "+v"(fr), "+v"(fq));
        const bool samp = u.pm >= 16; const int cond = samp ? 1 + ((u.pm - 16) >> 4) : 0;
        const float* gp = (const float*)(ws + WS_MOD) + LAYER * 5 * 3072 + 2048 + cond * 3072;
        const int rl0 = wr * 64 + fr, cl0 = u.pn * BM + wc * 32 + 8 * fq;
        bf16_t* const x1 = x1b_tile(ws, out, u.pm);
        bf16_t* const dst = LAYER == 0 ? x1 : (bf16_t*)(ws + WS_X2B) + (size_t)u.pm * (BM * DM);
        const float* const xin = samp ? xs + (size_t)(u.pm * BM - NPR) * DM : xp + (size_t)(u.pm * BM) * DM;
#pragma unroll
        for (int bj = 0; bj < 2; ++bj) { const int c = cl0 + bj * HALF; const f32x4 g0 = *(const f32x4*)(gp + c), g1 = *(const f32x4*)(gp + c + 4);
#pragma unroll
            for (int ai = 0; ai < 2; ++ai) { f32x4 xa[4], xb[4];
#pragma unroll
                for (int m = 0; m < 4; ++m) { const int rl = rl0 + ai * HALF + m * 16;
                    if (LAYER == 0) { const float* p = xin + (size_t)rl * DM + c; xa[m] = __builtin_nontemporal_load((const f32x4*)p); xb[m] = __builtin_nontemporal_load((const f32x4*)(p + 4)); }
                    else unpack8(__builtin_nontemporal_load((const u32x4*)(x1 + (size_t)rl * DM + c)), xa[m], xb[m]); }
#pragma unroll
                for (int m = 0; m < 4; ++m) { const int rl = rl0 + ai * HALF + m * 16;
                    const u32x4 ov = pack8(xa[m] + g0 * acc[ai][bj][m][0], xb[m] + g1 * acc[ai][bj][m][1]); bf16_t* op = dst + (size_t)rl * DM + c;
                    asm volatile("global_store_dwordx4 %0, %1, off sc1\n\ts_nop 1" :: "v"(op), "v"(ov) : "memory"); } } }
    }
};
struct EpiP7 {
    static constexpr bool PERM = true, AFTER_DRAIN = false;
    unsigned char* ws;
    __device__ __forceinline__ void operator()(const f32x4 (&acc)[2][2][4][2], const Unit& u, int wr, int wc, int fr, int fq) const {
        asm volatile("" : "+v"(fr), "+v"(fq));
        const int part = u.pn >> 2; bf16_t* dst = (bf16_t*)(ws + WS_A) + (size_t)part * (size_t)(20u << 20); const bool act = part == 2;
        const int row0 = u.pm * BM + wr * 64 + fr, col0 = (u.pn & 3) * BM + wc * 32 + 8 * fq;
#pragma unroll
        for (int ai = 0; ai < 2; ++ai)
#pragma unroll
            for (int m = 0; m < 4; ++m) { bf16_t* rowp = dst + (size_t)(row0 + ai * HALF + m * 16) * DM + col0;
#pragma unroll
                for (int bj = 0; bj < 2; ++bj) { f32x4 v0 = acc[ai][bj][m][0], v1 = acc[ai][bj][m][1]; if (act) { v0 = silu4(v0); v1 = silu4(v1); }
                    *(u32x4*)(rowp + bj * HALF) = pack8(v0, v1); } }
    }
};

template <class Epi, class Sched, bool ALIGN_EPI = false, bool SP2 = false>
__device__ __forceinline__ void gemm_phase(PG8_LAS unsigned char* lds, const Gemm g, const Sched& S, const Epi& E, const int wid  ) {
    const int lane = (int)__builtin_amdgcn_mbcnt_hi(~0u, __builtin_amdgcn_mbcnt_lo(~0u, 0u)), tid = wid * 64 + lane, wr = wid >> 2, wc = wid & 3, fr = lane & 15, fq = lane >> 4;
    const int K = g.K, nt = K / BK;
    unsigned voffA[2], voffB[2];
#pragma unroll
    for (int i = 0; i < 2; ++i) { int R, C; stage_rc(tid * 16 + i * 8192, R, C); const int Rb = Epi::PERM ? ((R & ~31) + perm32(R & 31)) : R;
        voffA[i] = (unsigned)(R * K + C) * 2u; voffB[i] = (unsigned)(Rb * K + C) * 2u; }
    const size_t kstep = (size_t)(BK * 2);
    const size_t hstep = (size_t)HALF * K * 2;
    const size_t tstep = 2 * hstep;
    const unsigned ldsw = (unsigned)wid * 1024u;
    const int aoff = lds_byte(wr * 64 + fr, fq * 8), boff = lds_byte(wc * 32 + fr, fq * 8);
#define PG8_SA(b, h) (((b) * 2 + (h)) * HTB)
#define PG8_SB(b, h) ((4 + (b) * 2 + (h)) * HTB)
#define PG8_STAGE(bufoff, gbase, voff) do { _Pragma("unroll") for (int _i = 0; _i < 2; ++_i) \
        __builtin_amdgcn_global_load_lds((const unsigned*)((const char*)(gbase) + (voff)[_i]), (PG8_LAS unsigned*)(lds + (bufoff) + ldsw + _i * 8192), 16, 0, 0); } while (0)
#define PG8_LDA(dst, b, h) do { _Pragma("unroll") for (int m = 0; m < 4; ++m) _Pragma("unroll") for (int k = 0; k < 2; ++k) dst[m][k] = *(const PG8_LAS bf16x8*)(lds + PG8_SA(b, h) + aoff + m * 2048 + k * 1024); } while (0)
#define PG8_LDB(dst, b, h) do { _Pragma("unroll") for (int n = 0; n < 2; ++n) _Pragma("unroll") for (int k = 0; k < 2; ++k) dst[n][k] = *(const PG8_LAS bf16x8*)(lds + PG8_SB(b, h) + boff + n * 2048 + k * 1024); } while (0)
#define PG8_MMA(ai, bj, At, Bt) do { __builtin_amdgcn_s_setprio(1); _Pragma("unroll") for (int m = 0; m < 4; ++m) _Pragma("unroll") for (int n = 0; n < 2; ++n) _Pragma("unroll") for (int k = 0; k < 2; ++k) \
        acc[ai][bj][m][n] = __builtin_amdgcn_mfma_f32_16x16x32_bf16(Bt[n][k], At[m][k], acc[ai][bj][m][n], 0, 0, 0); __builtin_amdgcn_s_setprio(0); } while (0)
#define PG8_WAIT_V(n) asm volatile("s_waitcnt vmcnt(" #n ")" ::: "memory")
#define PG8_WAIT_L(n) asm volatile("s_waitcnt lgkmcnt(" #n ")" ::: "memory")
#define PG8_BAR __builtin_amdgcn_s_barrier()
#define PG8_SCHED __builtin_amdgcn_sched_barrier(0)
    Unit cur, nxt; int ui = 0;
    if (!S.next(0, cur)) return;
    f32x4 acc[2][2][4][2];
#pragma unroll
    for (int a = 0; a < 2; ++a)
#pragma unroll
        for (int b = 0; b < 2; ++b)
#pragma unroll
            for (int m = 0; m < 4; ++m)
#pragma unroll
                for (int n = 0; n < 2; ++n) acc[a][b][m][n] = (f32x4){0.f, 0.f, 0.f, 0.f};
    bf16x8 At[4][2], B0[2][2], B1[2][2];
    const char* cA = (const char*)(cur.w ? g.A2 : g.A) + (size_t)cur.pm * tstep; const char* cB = (const char*)(cur.w ? g.Bt2 : g.Bt) + (size_t)cur.pn * tstep;
    S.a_ready(cur);
    if constexpr (SP2) {
        PG8_STAGE(PG8_SB(0, 0), cB, voffB); PG8_STAGE(PG8_SB(0, 1), cB + hstep, voffB); PG8_STAGE(PG8_SA(0, 0), cA, voffA); PG8_STAGE(PG8_SA(0, 1), cA + hstep, voffA);
        if (wr == 1) PG8_BAR;
        PG8_WAIT_V(2); PG8_BAR;
        PG8_STAGE(PG8_SB(1, 0), cB + kstep, voffB); PG8_STAGE(PG8_SA(1, 0), cA + kstep, voffA); PG8_STAGE(PG8_SB(1, 1), cB + hstep + kstep, voffB);
        PG8_WAIT_V(6); PG8_BAR;
    } else {
        PG8_STAGE(PG8_SB(0, 0), cB, voffB); PG8_STAGE(PG8_SA(0, 0), cA, voffA); PG8_STAGE(PG8_SB(0, 1), cB + hstep, voffB); PG8_STAGE(PG8_SA(0, 1), cA + hstep, voffA);
        if (wr == 1) PG8_BAR;
        PG8_WAIT_V(4); PG8_BAR;
        PG8_STAGE(PG8_SB(1, 0), cB + kstep, voffB); PG8_STAGE(PG8_SA(1, 0), cA + kstep, voffA); PG8_STAGE(PG8_SB(1, 1), cB + hstep + kstep, voffB);
        PG8_WAIT_V(6); PG8_BAR;
    }
    for (;;) {
        const bool has_next = S.next(ui + 1, nxt);
        const char* nA = has_next ? (const char*)(nxt.w ? g.A2 : g.A) + (size_t)nxt.pm * tstep : cA; const char* nB = has_next ? (const char*)(nxt.w ? g.Bt2 : g.Bt) + (size_t)nxt.pn * tstep : cB;
        for (int t = 0; t < nt; t += 2) {
            const bool last = (t == nt - 2);
            const char* a1 = cA + (size_t)(t + 1) * kstep;
            const char* a2 = last ? nA : cA + (size_t)(t + 2) * kstep; const char* b2 = last ? nB : cB + (size_t)(t + 2) * kstep;
            const char* a3 = a2 + kstep; const char* b3 = b2 + kstep;
            if (last && has_next) S.a_ready(nxt);
            if constexpr (SP2) {
            PG8_LDB(B0, 0, 0); PG8_LDB(B1, 0, 1); PG8_SCHED; PG8_LDA(At, 0, 0); PG8_STAGE(PG8_SA(1, 1), a1 + hstep, voffA);
            PG8_WAIT_V(8); PG8_WAIT_L(0); PG8_BAR; PG8_MMA(0, 0, At, B0); PG8_MMA(0, 1, At, B1); PG8_BAR; PG8_SCHED;
            PG8_LDA(At, 0, 1); PG8_STAGE(PG8_SB(0, 0), b2, voffB); PG8_STAGE(PG8_SB(0, 1), b2 + hstep, voffB); PG8_STAGE(PG8_SA(0, 0), a2, voffA);
            PG8_WAIT_V(8); PG8_WAIT_L(0); PG8_BAR; PG8_MMA(1, 0, At, B0); PG8_MMA(1, 1, At, B1); PG8_BAR; PG8_SCHED;
            PG8_LDB(B0, 1, 0); PG8_LDB(B1, 1, 1); PG8_SCHED; PG8_LDA(At, 1, 0); PG8_STAGE(PG8_SA(0, 1), a2 + hstep, voffA);
            PG8_WAIT_V(8); PG8_WAIT_L(0); PG8_BAR; PG8_MMA(0, 0, At, B0); PG8_MMA(0, 1, At, B1); PG8_BAR; PG8_SCHED;
            PG8_LDA(At, 1, 1); PG8_STAGE(PG8_SB(1, 0), b3, voffB); PG8_STAGE(PG8_SB(1, 1), b3 + hstep, voffB); PG8_STAGE(PG8_SA(1, 0), a3, voffA);
            PG8_WAIT_V(8); PG8_WAIT_L(0); PG8_BAR; PG8_MMA(1, 0, At, B0); PG8_MMA(1, 1, At, B1); PG8_BAR; PG8_SCHED;
            } else {
            PG8_LDB(B0, 0, 0); PG8_SCHED; PG8_LDA(At, 0, 0); PG8_STAGE(PG8_SA(1, 1), a1 + hstep, voffA);
            PG8_WAIT_L(8); PG8_BAR; PG8_WAIT_L(0); PG8_MMA(0, 0, At, B0); PG8_BAR; PG8_SCHED;
            PG8_LDB(B1, 0, 1); PG8_STAGE(PG8_SB(0, 0), b2, voffB);
            PG8_BAR; PG8_WAIT_L(0); PG8_MMA(0, 1, At, B1); PG8_BAR;
            PG8_LDA(At, 0, 1); PG8_STAGE(PG8_SA(0, 0), a2, voffA);
            PG8_BAR; PG8_WAIT_L(0); PG8_MMA(1, 0, At, B0); PG8_BAR; PG8_SCHED;
            PG8_STAGE(PG8_SB(0, 1), b2 + hstep, voffB);
            PG8_WAIT_V(6); PG8_BAR; PG8_MMA(1, 1, At, B1); PG8_BAR;
            PG8_LDB(B0, 1, 0); PG8_SCHED; PG8_LDA(At, 1, 0); PG8_STAGE(PG8_SA(0, 1), a2 + hstep, voffA);
            PG8_WAIT_L(8); PG8_BAR; PG8_WAIT_L(0); PG8_MMA(0, 0, At, B0); PG8_BAR; PG8_SCHED;
            PG8_LDB(B1, 1, 1); PG8_STAGE(PG8_SB(1, 0), b3, voffB);
            PG8_BAR; PG8_WAIT_L(0); PG8_MMA(0, 1, At, B1); PG8_BAR;
            PG8_LDA(At, 1, 1); PG8_STAGE(PG8_SA(1, 0), a3, voffA);
            PG8_BAR; PG8_WAIT_L(0); PG8_MMA(1, 0, At, B0); PG8_BAR; PG8_SCHED;
            PG8_STAGE(PG8_SB(1, 1), b3 + hstep, voffB);
            PG8_WAIT_V(6); PG8_BAR; PG8_MMA(1, 1, At, B1); PG8_BAR;
            }
        }
        if constexpr (ALIGN_EPI) { if (wr == 0) PG8_BAR; }
        if constexpr (!Epi::AFTER_DRAIN) { E(acc, cur, wr, wc, fr, fq); S.done(cur); }
        if (!has_next) break;
#pragma unroll
        for (int a = 0; a < 2; ++a)
#pragma unroll
            for (int b = 0; b < 2; ++b)
#pragma unroll
                for (int m = 0; m < 4; ++m)
#pragma unroll
                    for (int n = 0; n < 2; ++n) acc[a][b][m][n] = (f32x4){0.f, 0.f, 0.f, 0.f};
        cur = nxt; cA = nA; cB = nB; ++ui;
        if constexpr (ALIGN_EPI) { if (wr == 1) PG8_BAR; }
    }
    PG8_WAIT_V(0);
    if constexpr (!ALIGN_EPI) { if (wr == 0) PG8_BAR; }
    PG8_BAR;
    if constexpr (Epi::AFTER_DRAIN) { E.fused(acc, cur, wr, wc, fr, fq, lds, wid, lane); S.done(cur); }
#undef PG8_SA
#undef PG8_SB
#undef PG8_STAGE
#undef PG8_LDA
#undef PG8_LDB
#undef PG8_MMA
#undef PG8_WAIT_V
#undef PG8_WAIT_L
#undef PG8_BAR
#undef PG8_SCHED
}
}
#define GAS __attribute__((address_space(1)))
#define LAS __attribute__((address_space(3)))
typedef unsigned short bf16;
typedef unsigned v4u __attribute__((ext_vector_type(4)));
typedef float f32x4 __attribute__((ext_vector_type(4)));
typedef short bf16x8 __attribute__((ext_vector_type(8)));
typedef GAS unsigned gu32;
typedef GAS unsigned long long gu64;
#define RLX_AGENT __ATOMIC_RELAXED, __HIP_MEMORY_SCOPE_AGENT
#define LDS_WAIT() asm volatile("s_waitcnt lgkmcnt(0)" ::: "memory")
#define VM_WAIT() asm volatile("s_waitcnt vmcnt(0)" ::: "memory")
__device__ __forceinline__ unsigned long long rt() { return __builtin_amdgcn_s_memrealtime(); }

#define XB_TMO      128
#define XB_XCNT(j)  (256  + 64 * (j))
#define XB_XSUB(j)  (1280 + 64 * (j))
#define XB_XGEN(j)  (2304 + 64 * (j))
#define XB_TOP      3328
#define XB_TOPGEN   3392
#define XCD_BAR_WORDS 3456
#define XB_SPIN_CAP (1u << 18)

__device__ __forceinline__ unsigned xb_ld(unsigned* p)              { return __hip_atomic_load(p, __ATOMIC_RELAXED, __HIP_MEMORY_SCOPE_AGENT); }
__device__ __forceinline__ unsigned xb_add(unsigned* p, unsigned v) { return __hip_atomic_fetch_add(p, v, __ATOMIC_RELAXED, __HIP_MEMORY_SCOPE_AGENT); }
__device__ __forceinline__ unsigned xb_xcc_id() { return (unsigned)__builtin_amdgcn_s_getreg((3 << 11) | 20) & 0xFu; }
#define XB_SPIN(cond, bar) do { unsigned _sp = 0; while (cond) { __builtin_amdgcn_s_sleep(1); \
    if ((++_sp & 255u) == 0u) { if (xb_ld(&(bar)[XB_TMO])) break; if (_sp > XB_SPIN_CAP) { atomicAdd(&(bar)[XB_TMO], 1u); break; } } } } while (0)

struct XcdBarrier {
    unsigned* bar; unsigned x;
    volatile LAS unsigned* st;
};

__device__ __forceinline__ XcdBarrier xcd_barrier_post(unsigned* bar, volatile LAS unsigned* st, const bool t0) {
    XcdBarrier b; b.bar = bar; b.x = xb_xcc_id(); b.st = st;
    if (t0) (void)xb_add(&bar[XB_XCNT(b.x)], 1u);
    return b;
}
__device__ __forceinline__ void xcd_barrier_complete(unsigned* bar, unsigned x, unsigned& nloc, unsigned& nx) {
    const unsigned G = gridDim.x * gridDim.y * gridDim.z;
    unsigned sum, cnt, mine, sp = 0u;
    for (;;) {
        sum = 0u; cnt = 0u; mine = 0u;
#pragma unroll
        for (unsigned j = 0; j < 16; ++j) { const unsigned c = xb_ld(&bar[XB_XCNT(j)]); sum += c; cnt += (c > 0u) ? 1u : 0u; mine = (j == x) ? c : mine; }
        if (sum == G) break;
        __builtin_amdgcn_s_sleep(1);
        if ((++sp & 255u) == 0u) { if (xb_ld(&bar[XB_TMO])) break; if (sp > XB_SPIN_CAP) { atomicAdd(&bar[XB_TMO], 1u); break; } }
    }
    nloc = mine > 0u ? mine : 1u; nx = cnt > 0u ? cnt : 1u;
}

__device__ __forceinline__ void xcd_barrier(const XcdBarrier& b, const bool t0) {
    asm volatile("s_waitcnt vmcnt(0)" ::: "memory");
    __syncthreads();
    if (t0) {
        unsigned* bar = b.bar;
        __builtin_amdgcn_s_waitcnt(0);
        unsigned nloc = b.st[0], nx = b.st[1];
        if (nloc == 0u) { xcd_barrier_complete(bar, b.x, nloc, nx); b.st[0] = nloc; b.st[1] = nx; }
        const unsigned old = xb_add(&bar[XB_XSUB(b.x)], 1u);
        const unsigned gen = old / nloc;
        if (old + 1u == (gen + 1u) * nloc) {
            __builtin_amdgcn_fence(__ATOMIC_RELEASE, "agent");
            asm volatile("s_waitcnt vmcnt(0)" ::: "memory");
            const unsigned og = xb_add(&bar[XB_TOP], 1u);
            const unsigned tg = og / nx;
            if (og + 1u == (tg + 1u) * nx) xb_add(&bar[XB_TOPGEN], 1u);
            else XB_SPIN(xb_ld(&bar[XB_TOPGEN]) == tg, bar);
            __builtin_amdgcn_fence(__ATOMIC_ACQUIRE, "agent");
            xb_add(&bar[XB_XGEN(b.x)], 1u);
            asm volatile("s_waitcnt vmcnt(0)" ::: "memory");
        } else {
            XB_SPIN(xb_ld(&bar[XB_XGEN(b.x)]) == gen, bar);
            __builtin_amdgcn_fence(__ATOMIC_ACQUIRE, "agent");
            asm volatile("s_waitcnt vmcnt(0)" ::: "memory");
        }
    }
    __syncthreads();
}


constexpr int NWAVES = 8;
constexpr int RING_BYTES = 131072;
constexpr int LDSCTL_OFF = RING_BYTES, MISC_OFF = LDSCTL_OFF + 320;
constexpr int LDS_BYTES = 147456;
constexpr int CW_TMO = 0, CW_CODE = 1, CW_BAR = 4096;
static_assert((CW_BAR + 3456) * 4 <= (int)CTL_ZERO_BYTES, "ctl");

struct Args { const float* in[27]; float* out; unsigned char* ws; int ph_lo, ph_hi, grid, pad; };
typedef const Args __attribute__((address_space(4)))* ArgsP;
extern __shared__ __attribute__((aligned(16))) unsigned char g_lds[];
constexpr int CTXW_OFF = LDSCTL_OFF;
struct Ctx { ArgsP a; int wave, bid; };
__device__ __forceinline__ unsigned hw_slot() { return (unsigned)__builtin_amdgcn_s_getreg((5 << 11) | 4) & 63u; }
__device__ __forceinline__ Ctx get_ctx() {
    volatile LAS unsigned* cw = (volatile LAS unsigned*)((LAS unsigned char*)g_lds + CTXW_OFF);
    Ctx c; c.wave = __builtin_amdgcn_readfirstlane((int)cw[hw_slot()]); c.bid = __builtin_amdgcn_readfirstlane((int)cw[64]);
    const unsigned lo = (unsigned)__builtin_amdgcn_readfirstlane((int)cw[66]), hi = (unsigned)__builtin_amdgcn_readfirstlane((int)cw[67]);
    c.a = (ArgsP)(uintptr_t)(((unsigned long long)hi << 32) | lo); return c;
}
#define LANE_ID() ((int)__builtin_amdgcn_mbcnt_hi(~0u, __builtin_amdgcn_mbcnt_lo(~0u, 0u)))
enum { I_XP = 0, I_XS, I_C, I_CCKV, I_CKR, I_CCTX, I_NORMG, I_WMOD, I_BMOD, I_WINE, I_CONVW, I_CONVB, I_FW1, I_FB1, I_FW2, I_FB2, I_FW3, I_SKIP, I_QG, I_KVG, I_WUQ, I_WUKV, I_WOUTE, I_WINO, I_FNETW, I_WOUTO, I_FINALG };

__device__ __forceinline__ float wave_sum(float v) {
#pragma unroll
    for (int o = 1; o < 64; o <<= 1) v += __shfl_xor(v, o);
    return v;
}

__device__ __forceinline__ void transpose_item(const float* __restrict__ src, int pitch, int k0, int n0, bf16* __restrict__ dst, int K, float* scr, int lane) {
#pragma unroll 8
    for (int i = 0; i < 32; ++i) { const int kk = 2 * i + (lane >> 5); scr[kk * 33 + (lane & 31)] = src[(size_t)(k0 + kk) * pitch + n0 + (lane & 31)]; }
    __builtin_amdgcn_s_waitcnt(0xc07f); asm volatile("" ::: "memory");
    const int c = lane & 7;
#pragma unroll
    for (int j = 0; j < 4; ++j) { const int n = (lane >> 3) + 8 * j; const float* s = scr + (8 * c) * 33 + n;
        u32x4 o; o.x = pk2(s[0 * 33], s[1 * 33]); o.y = pk2(s[2 * 33], s[3 * 33]); o.z = pk2(s[4 * 33], s[5 * 33]); o.w = pk2(s[6 * 33], s[7 * 33]);
        *(u32x4*)(dst + (size_t)n * K + k0 + 8 * c) = o; }
    __builtin_amdgcn_s_waitcnt(0xc07f); asm volatile("" ::: "memory");
}

#define P0_CTX const Ctx cx_ = get_ctx(); ArgsP a = cx_.a; const int G = a->grid, bid = cx_.bid; const int wave = cx_.wave, lane = LANE_ID(), tid = wave * 64 + lane; \
    unsigned char* const ws = a->ws; float* const lf = (float*)lds; (void)G; (void)bid; (void)lane; (void)wave; (void)ws; (void)lf
constexpr int CW_Q0 = 64;
constexpr int CW_ADA = 128;
constexpr int CW_PC5 = 8192, CW_PC10 = 16384, CW_PR = 24576;
constexpr int SEG_N[5] = {192 + 64 + 3 + 320 + 194, 16 + 72 + 80 + 72 + 28, 64, 256 + 64, 64};
__device__ __forceinline__ void p0_ada_task(unsigned char* lds, int task) { P0_CTX;
    float* sc = lf; float* red = lf + 5 * 1024; float* MOD = (float*)(ws + WS_MOD);
    const int l = task / 96, n0 = (task % 96) * 32;
    for (int i = tid; i < 5 * 1024; i += 512) { const int cnd = i >> 10, k = i & 1023; const float x = cnd == 0 ? a->in[I_CCTX][k] : a->in[I_C][(cnd - 1) * 1024 + k]; sc[i] = x / (1.0f + expf(-x)); }
    __syncthreads();
    const int col = tid & 31, ks = tid >> 5; float acc[5] = {0.f, 0.f, 0.f, 0.f, 0.f};
    const float* w = a->in[I_WMOD] + (size_t)l * 1024 * 3072 + n0 + col;
#pragma unroll 16
    for (int k = ks * 64; k < ks * 64 + 64; ++k) { const float wv = w[(size_t)k * 3072];
#pragma unroll
        for (int cnd = 0; cnd < 5; ++cnd) acc[cnd] += sc[cnd * 1024 + k] * wv; }
#pragma unroll
    for (int cnd = 0; cnd < 5; ++cnd) red[(ks * 5 + cnd) * 32 + col] = acc[cnd];
    __syncthreads();
    if (tid < 160) { const int cnd = tid >> 5, cc = tid & 31; float s = a->in[I_BMOD][l * 3072 + n0 + cc];
        for (int k2 = 0; k2 < 16; ++k2) s += red[(k2 * 5 + cnd) * 32 + cc];
        __hip_atomic_store(MOD + (l * 5 + cnd) * 3072 + n0 + cc, s, __ATOMIC_RELAXED, __HIP_MEMORY_SCOPE_AGENT); }
    asm volatile("s_waitcnt vmcnt(0)" ::: "memory");
    __syncthreads();
    if (tid == 0) __hip_atomic_fetch_add((unsigned*)(ws + WS_CTL) + CW_ADA, 1u, __ATOMIC_RELAXED, __HIP_MEMORY_SCOPE_AGENT);
}
__device__ __forceinline__ void p0_filter_task(unsigned char* lds, int task) { P0_CTX;
    float* z = lf; float* h1 = lf + 1056; float* h2 = h1 + 2048;
    float* PS = (float*)(ws + WS_PS);
    const float *w1 = a->in[I_FW1], *b1 = a->in[I_FB1], *w2 = a->in[I_FW2], *b2 = a->in[I_FB2], *w3 = a->in[I_FW3];
    const int sel = task < 128 ? 0 : 1, chunk = sel ? task - 128 : task, L = sel ? 256 : 4096, p0 = chunk * 32;
    bf16* KF = (bf16*)(ws + (sel ? WS_KF1 : WS_KF0));
    for (int o = tid; o < 32 * 33; o += 512) { const int p = o / 33, i = o % 33, pos = p0 + p; float v;
        if (i == 0) v = (float)pos / (float)(L - 1);
        else { const int bi = (i - 1) & 15; const float f = 1e-4f + (float)bi * ((15.0f - 1e-4f) / 15.0f), rev = f * ((float)pos / (float)L);
            v = (i <= 16) ? __builtin_amdgcn_cosf(rev) : -__builtin_amdgcn_sinf(rev); }
        z[p * 33 + i] = v; }
    __syncthreads();
    for (int o = tid; o < 2048; o += 512) { const int p = o >> 6, j = o & 63; float s = b1[j];
#pragma unroll 11
        for (int i = 0; i < 33; ++i) s += z[p * 33 + i] * w1[i * 64 + j];
        h1[o] = __sinf(s); }
    __syncthreads();
    for (int o = tid; o < 2048; o += 512) { const int p = o >> 6, j = o & 63; float s = b2[j];
#pragma unroll 16
        for (int i = 0; i < 64; ++i) s += h1[p * 64 + i] * w2[i * 64 + j];
        h2[p * 65 + j] = __sinf(s); }
    __syncthreads();
    const int r32 = lane & 31, hi = lane >> 5;
    bf16x8 Ah[4], Al[4];
#pragma unroll
    for (int sI = 0; sI < 4; ++sI)
#pragma unroll
        for (int e = 0; e < 8; ++e) { const float x = h2[r32 * 65 + 16 * sI + 8 * hi + e]; const unsigned h = f2bf(x); Ah[sI][e] = (short)h; Al[sI][e] = (short)f2bf(x - bf2f(h)); }
    const float* w3l = w3 + (size_t)(8 * hi) * 1024 + (4 * wave) * 32 + r32;
#pragma unroll 1
    for (int nbi = 0; nbi < 4; ++nbi) { const int n = (4 * wave + nbi) * 32 + r32, dir = n >> 9, c = n & 511;
        float braw[32];
#pragma unroll
        for (int q = 0; q < 32; ++q) braw[q] = w3l[(size_t)(16 * (q >> 3) + (q & 7)) * 1024 + nbi * 32];
        f32x16 acc = {};
#pragma unroll
        for (int sI = 0; sI < 4; ++sI) { bf16x8 Bh, Bl;
#pragma unroll
            for (int e = 0; e < 8; ++e) { const float x = braw[8 * sI + e]; const unsigned h = f2bf(x); Bh[e] = (short)h; Bl[e] = (short)f2bf(x - bf2f(h)); }
            acc = __builtin_amdgcn_mfma_f32_32x32x16_bf16(Ah[sI], Bh, acc, 0, 0, 0); acc = __builtin_amdgcn_mfma_f32_32x32x16_bf16(Al[sI], Bh, acc, 0, 0, 0); acc = __builtin_amdgcn_mfma_f32_32x32x16_bf16(Ah[sI], Bl, acc, 0, 0, 0); }
        const float delta = 3.0701134573253946f + (float)c * ((15.350567286626973f - 3.0701134573253946f) / 511.0f); float ps = 0.f;
        unsigned char* tile = lds + 32768 + wave * 2560;
#pragma unroll
        for (int g = 0; g < 4; ++g) { const int q0 = p0 + 8 * g + 4 * hi; unsigned hv[4];
#pragma unroll
            for (int e = 0; e < 4; ++e) { const float t = (float)(q0 + e) / (float)(L - 1); const float v = acc[4 * g + e] * __expf(-t * delta); ps += fabsf(v); hv[e] = f2bf(v); }
            *(u32x2*)(tile + r32 * 80 + (8 * g + 4 * hi) * 2) = (u32x2){hv[0] | (hv[1] << 16), hv[2] | (hv[3] << 16)}; }
        ps += __shfl_xor(ps, 32);
        if (hi == 0) PS[(size_t)(sel * 256 + chunk) * 1024 + n] = ps;
#pragma unroll
        for (int j = 0; j < 2; ++j) { const int ch = (lane >> 2) + 16 * j, piece = lane & 3; const u32x4 w = *(const u32x4*)(tile + ch * 80 + piece * 16);
            bf16* row = KF + (size_t)(((4 * wave + nbi) * 32 + ch) & 511) * (2 * L);
            if (dir == 0) *(u32x4*)(row + L + p0 + 8 * piece) = w;
            else {
                bf16* bp = row + (L - p0 - 8 * piece - 7);
                bp[0] = (bf16)(w.w >> 16);
                *(unsigned*)(bp + 1) = (w.w & 0xffffu) | (w.z & 0xffff0000u);
                *(u32x2*)(bp + 3) = (u32x2){(w.z & 0xffffu) | (w.y & 0xffff0000u), (w.y & 0xffffu) | (w.x & 0xffff0000u)};
                if (p0 + 8 * piece == 0) row[0] = (bf16)0u; else bp[7] = (bf16)(w.x & 0xffffu); }
        }
    }
}
__device__ __forceinline__ void p0_pq_task(unsigned char* lds, int task) { P0_CTX;
    float* tab = lf;
    if (tid < 128) { tab[2 * tid] = (float)cos(6.283185307179586476925 * (double)tid / 128.0); tab[2 * tid + 1] = (float)sin(6.283185307179586476925 * (double)tid / 128.0); }
    __syncthreads();
    float* PQ = (float*)(ws + WS_PQ); const int half = task >> 3, g = task & 7; const float* Wf = a->in[I_FNETW] + (size_t)g * 16384;
    const int r32 = lane & 31, hi = lane >> 5, c = 32 * (wave >> 1) + r32;
#pragma unroll 1
    for (int nbi = 0; nbi < 2; ++nbi) { const int d = 32 * (2 * (wave & 1) + nbi) + r32;
        f32x16 acc = {};
#pragma unroll 16
        for (int kk = 0; kk < 64; ++kk) { const int j = 2 * kk + hi; acc = __builtin_amdgcn_mfma_f32_32x32x2f32(tab[2 * ((c * j) & 127) + half], Wf[(size_t)j * 128 + d], acc, 0, 0, 0); }
#pragma unroll
        for (int r = 0; r < 16; ++r) { const int cr = 32 * (wave >> 1) + (r & 3) + 8 * (r >> 2) + 4 * hi; PQ[(size_t)((half * 8 + g) * 128 + cr) * 128 + d] = acc[r] * 0.08838834764831845f; } }
}
__device__ __forceinline__ void p0_wt_task(unsigned char* lds, int task, int item0, int item1) { P0_CTX;
    float* scr = lf + wave * (64 * 33);
    const int it = item0 + task * NWAVES + wave;
    if (it < item1) {
        int r = it, si, pitch, K, kb, nb, n0; size_t doff;
        if (r < 1552) { si = I_WINE; pitch = 3104; K = 1024; kb = r / 97; nb = r % 97; n0 = 32 * nb; const int drow = nb < 80 ? 32 * nb : (nb == 80 ? 3072 : 32 * nb - 32); doff = WS_WT_IN_E + (size_t)drow * 2048; }
        else if ((r -= 1552) < 96) { si = I_WUQ; pitch = 768; K = 256; kb = r / 24; nb = r % 24; n0 = 32 * nb; doff = WS_WT_UQ + (size_t)(32 * nb) * 512; }
        else if ((r -= 96) < 128) { si = I_WUKV; pitch = 1024; K = 256; kb = r / 32; nb = r % 32; n0 = 32 * nb; const int h = nb >> 2, part = nb & 3;
            doff = (part < 2) ? WS_WT_UK + (size_t)(h * 64 + 32 * part) * 512 : WS_WT_UV + (size_t)(h * 64 + 32 * (part - 2)) * 512; }
        else if ((r -= 128) < 512) { si = I_WOUTE; pitch = 1024; K = 1024; kb = r / 32; nb = r % 32; n0 = 32 * nb; doff = WS_WT_OUT_E + (size_t)(32 * nb) * 2048; }
        else if ((r -= 512) < 512) { si = I_WINO; pitch = 2048; K = 1024; kb = r / 32; nb = r % 32; n0 = 1024 + 32 * nb; doff = WS_WT_IN_O + (size_t)(2048 + 32 * nb) * 2048; }
        else { r -= 512; si = I_WOUTO; pitch = 1024; K = 1024; kb = r / 32; nb = r % 32; n0 = 32 * nb; doff = WS_WT_OUT_O + (size_t)(32 * nb) * 2048; }
        transpose_item(a->in[si], pitch, 64 * kb, n0, (bf16*)(ws + doff), K, scr, lane);
    }
}
__device__ __forceinline__ void p0_misc_task(unsigned char* lds, int task) { P0_CTX;
#pragma unroll 1
    for (int it = 0; it < 4; ++it) {
        if (task < 14) { const int i = task * 2048 + it * 512 + tid; ((u32x4*)((bf16*)(ws + WS_WT_IN_E) + (size_t)3104 * 1024))[i] = (u32x4){0u, 0u, 0u, 0u}; }
        else if (task < 78) { const int i = (task - 14) * 2048 + it * 512 + tid; bf16* CKV = (bf16*)(ws + WS_CKV); const float* src = a->in[I_CCKV];
            const int e = i * 4, b = e >> 17, p = (e >> 8) & 511, c = e & 255; const f32x4 v = *(const f32x4*)(src + e);
            u32x2 o; o.x = pk2(v[0], v[1]); o.y = pk2(v[2], v[3]); *(u32x2*)(CKV + (size_t)(NPR + b * LKS + p) * 256 + c) = o; }
        else if (task < 86) { const int i = (task - 78) * 2048 + it * 512 + tid; bf16* KR = (bf16*)(ws + WS_KR); const float* src = a->in[I_CKR];
            const int e = i * 4, b = e >> 14, p = (e >> 5) & 511, c = e & 31; const f32x4 v = *(const f32x4*)(src + e);
            u32x2 o; o.x = pk2(v[0], v[1]); o.y = pk2(v[2], v[3]); *(u32x2*)(KR + (size_t)(NPR + b * LKS + p) * 32 + c) = o; }
        else { const int i = (task - 86) * 2048 + it * 512 + tid;
            if (i < 512) { float* rope = (float*)(ws + WS_ROPE); const int pos = i >> 3, f = i & 7; const double ang = (double)pos * pow(10000.0, -(double)f / 8.0); rope[2 * i] = (float)cos(ang); rope[2 * i + 1] = (float)sin(ang); }
            else if (i < 512 + 4416) { float* tw = (float*)(ws + WS_TW); const int j = i - 512; int m, N; if (j < 4096) { m = j; N = 4096; } else if (j < 4352) { m = j - 4096; N = 256; } else { m = j - 4352; N = 64; }
                const double ang = 6.283185307179586476925 * (double)m / (double)N; tw[2 * j] = (float)cos(ang); tw[2 * j + 1] = (float)sin(ang); } }
    }
}
__device__ __forceinline__ void krope_task(unsigned char* lds, int task) { P0_CTX;
    const bf16* H = (const bf16*)(ws + WS_H); const bf16* W = (const bf16*)(ws + WS_WT_IN_E) + (size_t)3072 * 1024; bf16* KR = (bf16*)(ws + WS_KR);
    const float* rope = (const float*)(ws + WS_ROPE); float* st_krope = a->out + (size_t)NTOK * DM + (size_t)NPR * 256;
    const int r32 = lane & 31, hi = lane >> 5, row0 = task * 256 + wave * 32;
    unsigned char* sa = lds + wave * 9216; unsigned char* sw = sa + 4608;
    const int sr = lane >> 3, sc = lane & 7;
    const bf16* ga = H + (size_t)(row0 + sr) * 1024 + sc * 8; const bf16* gw = W + (size_t)sr * 1024 + sc * 8;
    u32x4 ra[4], rw[4];
#pragma unroll
    for (int j = 0; j < 4; ++j) { ra[j] = *(const u32x4*)(ga + j * 8192); rw[j] = *(const u32x4*)(gw + j * 8192); }
    f32x16 acc = {};
#pragma unroll 1
    for (int ch = 0; ch < 16; ++ch) {
#pragma unroll
        for (int j = 0; j < 4; ++j) { *(u32x4*)(sa + (8 * j + sr) * 144 + sc * 16) = ra[j]; *(u32x4*)(sw + (8 * j + sr) * 144 + sc * 16) = rw[j]; }
        if (ch < 15) {
#pragma unroll
            for (int j = 0; j < 4; ++j) { ra[j] = *(const u32x4*)(ga + j * 8192 + (ch + 1) * 64); rw[j] = *(const u32x4*)(gw + j * 8192 + (ch + 1) * 64); } }
#pragma unroll
        for (int ks = 0; ks < 4; ++ks) { const bf16x8 A = *(const bf16x8*)(sa + r32 * 144 + (16 * ks + 8 * hi) * 2), B = *(const bf16x8*)(sw + r32 * 144 + (16 * ks + 8 * hi) * 2);
            acc = __builtin_amdgcn_mfma_f32_32x32x16_bf16(A, B, acc, 0, 0, 0); }
    }
    const bool samp = task >= 16; const int n = r32, fa = n >> 4, fp = (n >> 3) & 1, ff = n & 7;
#pragma unroll
    for (int r = 0; r < 16; ++r) { const int row = row0 + (r & 3) + 8 * (r >> 2) + 4 * hi; float x = acc[r];
        if (!samp) { st_krope[(size_t)row * 32 + n] = x; KR[(size_t)row * 32 + n] = (bf16)f2bf(x); }
        else { const float px = __shfl_xor(x, 8); const int s = row - NPR, t = s & 4095, pos = fa ? (t & 63) : (t >> 6); const float cs = rope[(pos * 8 + ff) * 2], sn = rope[(pos * 8 + ff) * 2 + 1];
            x = fp ? (px * sn + x * cs) : (x * cs - px * sn);
            KR[(size_t)(NPR + (s >> 12) * LKS + PAST + t) * 32 + n] = (bf16)f2bf(x); } }
}
__device__ __forceinline__ void norm_mod_row(const float* __restrict__ xrow, bf16* __restrict__ hrow, const float* __restrict__ g, const float* __restrict__ shift, const float* __restrict__ scale, int lane);
__device__ __forceinline__ void norm0_task(unsigned char* lds, int task) { P0_CTX;
    if (wave == 0) { unsigned spins = 0;
        while ((unsigned)__builtin_amdgcn_readfirstlane((int)__hip_atomic_load((unsigned*)(ws + WS_CTL) + CW_ADA, __ATOMIC_RELAXED, __HIP_MEMORY_SCOPE_AGENT)) < 192u) {
            __builtin_amdgcn_s_sleep(2);
            if (++spins > (1u << 22)) { if (lane == 0) __hip_atomic_store((unsigned*)(ws + WS_CTL) + CW_TMO, 1u, __ATOMIC_RELAXED, __HIP_MEMORY_SCOPE_AGENT); break; } }
        __builtin_amdgcn_fence(__ATOMIC_ACQUIRE, "agent");
        asm volatile("s_waitcnt vmcnt(0)" ::: "memory"); }
    __syncthreads();
    const float* MOD = (const float*)(ws + WS_MOD); const float* g = a->in[I_NORMG]; bf16* H = (bf16*)(ws + WS_H);
    const int r0 = task * 64 + wave * 8; const int cond = r0 < NPR ? 0 : 1 + ((r0 - NPR) >> 12);
#pragma unroll 4
    for (int i = 0; i < 8; ++i) { const int r = r0 + i; const float* xrow = r < NPR ? a->in[I_XP] + (size_t)r * DM : a->in[I_XS] + (size_t)(r - NPR) * DM;
        norm_mod_row(xrow, H + (size_t)r * DM, g, MOD + cond * 3072, MOD + cond * 3072 + 1024, lane); }
}
__device__ __forceinline__ void fnet_fold_task(unsigned char* lds, int task);
__device__ __forceinline__ void drain_segment(unsigned char* lds, const int seg) {
    for (;;) {
        int t;
        { P0_CTX; volatile LAS unsigned* cwl = (volatile LAS unsigned*)((LAS unsigned char*)g_lds + CTXW_OFF);
          __syncthreads();
          if (tid == 0) cwl[70] = __hip_atomic_fetch_add((unsigned*)(ws + WS_CTL) + CW_Q0 + seg, 1u, __ATOMIC_RELAXED, __HIP_MEMORY_SCOPE_AGENT);
          __syncthreads();
          t = __builtin_amdgcn_readfirstlane((int)cwl[70]); }
        if (t >= SEG_N[seg]) break;
        if (seg == 0) { if (t < 192) p0_ada_task(lds, t); else if (t < 256) p0_filter_task(lds, 72 + (t - 192)); else if (t < 259) p0_misc_task(lds, 86 + (t - 256)); else if (t < 579) norm0_task(lds, t - 259);
                        else p0_wt_task(lds, t - 579, 0, 1552); }
        else if (seg == 1) { if (t < 16) p0_pq_task(lds, t); else if (t < 88) p0_filter_task(lds, t - 16); else if (t < 168) krope_task(lds, t - 88); else if (t < 240) p0_misc_task(lds, 14 + (t - 168));
                             else p0_wt_task(lds, t - 240, 1552, 1776); }
        else if (seg == 2) p0_wt_task(lds, t, 1776, 2288);
        else if (seg == 3) { if (t < 256) fnet_fold_task(lds, t); else p0_wt_task(lds, t - 256, 2288, 2800); }
        else p0_wt_task(lds, t, 2800, 3312);
    }
    __syncthreads();
}

__device__ __forceinline__ void norm_mod_row(const float* __restrict__ xrow, bf16* __restrict__ hrow, const float* __restrict__ g, const float* __restrict__ shift, const float* __restrict__ scale, int lane) {
    f32x4 v[4]; float s = 0.f;
#pragma unroll
    for (int j = 0; j < 4; ++j) { v[j] = __builtin_nontemporal_load((const f32x4*)(xrow + 4 * lane + 256 * j)); s += (v[j][0] * v[j][0] + v[j][1] * v[j][1]) + (v[j][2] * v[j][2] + v[j][3] * v[j][3]); }
    const float rs = 1.0f / sqrtf(wave_sum(s) * (1.0f / 1024.0f) + EPS);
#pragma unroll
    for (int j = 0; j < 4; ++j) { const int c = 4 * lane + 256 * j; const f32x4 gg = *(const f32x4*)(g + c), sh = *(const f32x4*)(shift + c), sc = *(const f32x4*)(scale + c);
        const f32x4 h = (v[j] * rs * gg) * (sc + 1.0f) + sh; u32x2 o; o.x = pk2(h[0], h[1]); o.y = pk2(h[2], h[3]); *(u32x2*)(hrow + c) = o; }
}
__device__ __forceinline__ void norm_mod_row_b(const bf16* __restrict__ xrow, bf16* __restrict__ hrow, const float* __restrict__ g, const float* __restrict__ shift, const float* __restrict__ scale, int lane) {
    f32x4 v[4]; float s = 0.f;
#pragma unroll
    for (int j = 0; j < 2; ++j) unpack8(__builtin_nontemporal_load((const u32x4*)(xrow + 8 * lane + 512 * j)), v[2 * j], v[2 * j + 1]);
#pragma unroll
    for (int j = 0; j < 4; ++j) s += (v[j][0] * v[j][0] + v[j][1] * v[j][1]) + (v[j][2] * v[j][2] + v[j][3] * v[j][3]);
    const float rs = 1.0f / sqrtf(wave_sum(s) * (1.0f / 1024.0f) + EPS);
#pragma unroll
    for (int j = 0; j < 2; ++j) { const int c = 8 * lane + 512 * j; f32x4 h[2];
#pragma unroll
        for (int e = 0; e < 2; ++e) { const f32x4 gg = *(const f32x4*)(g + c + 4 * e), sh = *(const f32x4*)(shift + c + 4 * e), sc = *(const f32x4*)(scale + c + 4 * e); h[e] = (v[2 * j + e] * rs * gg) * (sc + 1.0f) + sh; }
        u32x4 o; o.x = pk2(h[0][0], h[0][1]); o.y = pk2(h[0][2], h[0][3]); o.z = pk2(h[1][0], h[1][1]); o.w = pk2(h[1][2], h[1][3]);
        bf16* hp = hrow + c; asm volatile("global_store_dwordx4 %0, %1, off sc1" :: "v"(hp), "v"(o) : "memory"); }
}
__device__ __forceinline__ void fnet_fold_task(unsigned char* lds, int task) { P0_CTX;
    constexpr int WUP = 130, PQP = 160;
    float* wu = (float*)lds;
    float* pq = wu + 64 * WUP;
    const float* PQ = (const float*)(ws + WS_PQ); const float* W = a->in[I_WINO]; bf16* WT = (bf16*)(ws + WS_WT_IN_O);
    const int half = task >> 7, g = (task >> 4) & 7, k0 = (task & 15) * 64;
    for (int i = tid; i < 64 * 128; i += 512) { const int k = i >> 7, c = i & 127; wu[k * WUP + c] = W[(size_t)(k0 + k) * 2048 + g * 128 + c]; }
    for (int i = tid; i < 128 * 128; i += 512) pq[(i >> 7) * PQP + (i & 127)] = PQ[(size_t)(half * 8 + g) * 16384 + i];
    __syncthreads();
    const int r32 = lane & 31, hi = lane >> 5, kb = wave >> 2, db = wave & 3;
    const float* ap = wu + (kb * 32 + r32) * WUP + hi; const float* bp = pq + hi * PQP + db * 32 + r32;
    f32x16 acc = {};
#pragma unroll 16
    for (int kk = 0; kk < 64; ++kk) acc = __builtin_amdgcn_mfma_f32_32x32x2f32(ap[2 * kk], bp[2 * kk * PQP], acc, 0, 0, 0);
    bf16* dst = WT + (size_t)(half * 1024 + g * 128 + db * 32 + r32) * 1024 + k0 + kb * 32 + 4 * hi;
#pragma unroll
    for (int q = 0; q < 4; ++q) { u32x2 o; o.x = pk2(acc[4 * q], acc[4 * q + 1]); o.y = pk2(acc[4 * q + 2], acc[4 * q + 3]); *(u32x2*)(dst + 8 * q) = o; }
}
__device__ __forceinline__ void panel_wait(unsigned* pcw, unsigned* tmo, int wave, int lane) {
    if (wave == 0) { unsigned spins = 0;
        while ((unsigned)__builtin_amdgcn_readfirstlane((int)__hip_atomic_load(pcw, __ATOMIC_RELAXED, __HIP_MEMORY_SCOPE_AGENT)) < 32u) {
            __builtin_amdgcn_s_sleep(2);
            if (++spins > (1u << 22)) { if (lane == 0) __hip_atomic_store(tmo, 1u, __ATOMIC_RELAXED, __HIP_MEMORY_SCOPE_AGENT); break; } }
        __builtin_amdgcn_fence(__ATOMIC_ACQUIRE, "agent");
        asm volatile("s_waitcnt vmcnt(0)" ::: "memory"); }
    __syncthreads();
}
template <bool LAYER1>
__device__ __forceinline__ void panel_queue(unsigned char* lds, const int qw = (LAYER1 ? 5 : 6), const int t0 = 0, const int nt = NTOK / 64) {
    for (;;) {
        int t;
        { P0_CTX; volatile LAS unsigned* cwl = (volatile LAS unsigned*)((LAS unsigned char*)g_lds + CTXW_OFF);
          __syncthreads();
          if (tid == 0) cwl[70] = __hip_atomic_fetch_add((unsigned*)(ws + WS_CTL) + CW_Q0 + qw, 1u, __ATOMIC_RELAXED, __HIP_MEMORY_SCOPE_AGENT);
          __syncthreads();
          t = __builtin_amdgcn_readfirstlane((int)cwl[70]); }
        if (t >= nt) break;
        t += t0;
        P0_CTX; const int pnl = t >> 2;
        panel_wait((unsigned*)(ws + WS_CTL) + (LAYER1 ? CW_PC5 : CW_PC10) + 64 * pnl, (unsigned*)(ws + WS_CTL) + CW_TMO, wave, lane);
        if (LAYER1) {
            const float* MOD = (const float*)(ws + WS_MOD) + 5 * 3072; const float* g = a->in[I_NORMG] + 1024; bf16* H = (bf16*)(ws + WS_H);
            const int cond = pnl < 16 ? 0 : 1 + ((pnl - 16) >> 4);
#pragma unroll 4
            for (int i = 0; i < 8; ++i) { const int r = t * 64 + wave * 8 + i; norm_mod_row_b(x1b_tile(ws, a->out, pnl) + (size_t)(r & 255) * DM, H + (size_t)r * DM, g, MOD + cond * 3072, MOD + cond * 3072 + 1024, lane); }
            asm volatile("s_waitcnt vmcnt(0)" ::: "memory");
            if (lane == 0) __hip_atomic_fetch_add((unsigned*)(ws + WS_CTL) + CW_PR + 64 * pnl, 1u, __ATOMIC_RELAXED, __HIP_MEMORY_SCOPE_AGENT);
        } else {
            const float* g = a->in[I_FINALG]; const bf16* X2B = (const bf16*)(ws + WS_X2B);
#pragma unroll 4
            for (int i = 0; i < 8; ++i) { const int r = t * 64 + wave * 8 + i; float* y = a->out + (size_t)r * DM; f32x4 v[4]; float s = 0.f;
#pragma unroll
                for (int j = 0; j < 2; ++j) unpack8(__builtin_nontemporal_load((const u32x4*)(X2B + (size_t)r * DM + 8 * lane + 512 * j)), v[2 * j], v[2 * j + 1]);
#pragma unroll
                for (int j = 0; j < 4; ++j) s += (v[j][0] * v[j][0] + v[j][1] * v[j][1]) + (v[j][2] * v[j][2] + v[j][3] * v[j][3]);
                const float rs = 1.0f / sqrtf(wave_sum(s) * (1.0f / 1024.0f) + EPS);
#pragma unroll
                for (int j = 0; j < 4; ++j) { const int cc = 8 * lane + 512 * (j >> 1) + 4 * (j & 1); *(f32x4*)(y + cc) = v[j] * rs * *(const f32x4*)(g + cc); } }
        }
    }
    __syncthreads();
}
__device__ __forceinline__ void state_fix_phase(ArgsP a, int tid, int bid, int G) {
    float* st = a->out + (size_t)NTOK * DM; const float* ssq = (const float*)(a->ws + WS_SSQKV);
    for (int i = bid * 512 + tid; i < NPR * 256 / 4; i += G * 512) { const int r = i >> 6; const f32x4 s4 = *(const f32x4*)(ssq + (size_t)r * 4);
        const float rs = 1.0f / sqrtf(((s4[0] + s4[1]) + (s4[2] + s4[3])) * (1.0f / 256.0f) + EPS); f32x4* p = (f32x4*)st + i; *p = *p * rs; }
}

template <bool SAMPLE> struct HyCfg;
template <> struct HyCfg<true>  { static constexpr int L = LSM, NB = 4,  NCH = 1, CPP = 16448, ZB = 7, NBLK = 78, VBATCH = 11328, VOFF = 4 * 16448, CHB = 4 * 16448 + 4 * 11328, TMP = CHB, MISC = TMP + 2 * LSM * 2, TOK0 = NPR; };
template <> struct HyCfg<false> { static constexpr int L = LPR, NB = 16, NCH = 4, CPP = 1088,  ZB = 1, NBLK = 6,  VBATCH = 864,   VOFF = 4 * 1088,  CHB = 4 * 1088 + 16 * 864,   TMP = 4 * CHB, MISC = TMP + 4 * 2 * LPR * 2, TOK0 = 0; };
constexpr int HY_BLK = 144;
template <bool SAMPLE>
__device__ __forceinline__ void hyena_mfma_unit(ArgsP a, unsigned char* lds, int unit, int tid, int lane, int wave) {
    typedef HyCfg<SAMPLE> C; constexpr int L = C::L, NB = C::NB, NCH = C::NCH;
    const int c0 = unit * NCH;
    const bf16* UT = (const bf16*)(a->ws + WS_UT); bf16* YT = (bf16*)(a->ws + WS_YT);
    const bf16* KF = (const bf16*)(a->ws + (SAMPLE ? WS_KF0 : WS_KF1));
    const float* cw = a->in[I_CONVW]; const float* cb = a->in[I_CONVB];
    float* misc = (float*)(lds + C::MISC);
    __syncthreads();
    if (wave < NCH) { const float* PS = (const float*)(a->ws + WS_PS) + (size_t)(SAMPLE ? 0 : 256) * 1024; const int c = c0 + wave; float s = 0.f;
        for (int ch = lane; ch < L / 32; ch += 64) s += PS[(size_t)ch * 1024 + c] + PS[(size_t)ch * 1024 + 512 + c];
        s = wave_sum(s); if (lane == 0) misc[wave] = 1.0f / s; }
#pragma unroll
    for (int it = 0; it < (NCH * 2 * L / 8 + 511) / 512; ++it) { const int q = tid + it * 512; if (q < NCH * 2 * L / 8) *(u32x4*)(lds + C::TMP + 16 * q) = *(const u32x4*)(KF + (size_t)c0 * (2 * L) + 8 * q); }
    __syncthreads();
    { constexpr int QPC = (2 * L + 8) / 8;
      for (int ch = tid; ch < NCH * 4 * QPC; ch += 512) { const int cc = ch / (4 * QPC), rem = ch - cc * (4 * QPC), sg = rem / QPC, q = rem - sg * QPC, T = 2 * L - 8 * q - sg; unsigned w[4];
          const bf16* tmp = (const bf16*)(lds + C::TMP) + cc * (2 * L);
#pragma unroll
          for (int e2 = 0; e2 < 4; ++e2) { const int i0 = T - 2 * e2, i1 = i0 - 1;
              const unsigned lo = (i0 >= 0 && i0 < 2 * L) ? (unsigned)tmp[i0] : 0u, hi = (i1 >= 0 && i1 < 2 * L) ? (unsigned)tmp[i1] : 0u; w[e2] = lo | (hi << 16); }
          *(u32x4*)(lds + cc * C::CHB + sg * C::CPP + 16 * q) = (u32x4){w[0], w[1], w[2], w[3]}; } }
    {
#pragma unroll 2
        for (int it = 0; it < NCH * NB * L / 8 / 512; ++it) { const int ch = tid + it * 512, cc = ch / (NB * L / 8), rem = ch - cc * (NB * L / 8), b = rem / (L / 8), s0 = (rem - b * (L / 8)) * 8, tok = C::TOK0 + b * L + s0; const int c = c0 + cc;
            const bf16* r1 = UT + (size_t)(512 + c) * NTOK; const bf16* rv = UT + (size_t)(1024 + c) * NTOK;
            const float a0 = cw[512 + c], a1 = cw[1536 + 512 + c], a2 = cw[3072 + 512 + c], ab = cb[512 + c];
            const float v0 = cw[1024 + c], v1 = cw[1536 + 1024 + c], v2 = cw[3072 + 1024 + c], vb = cb[1024 + c];
            const u32x4 xa = *(const u32x4*)(r1 + tok), xv = *(const u32x4*)(rv + tok);
            float fa[10], fv[10];
            fa[0] = s0 > 0 ? bf2f(r1[tok - 1]) : 0.f; fv[0] = s0 > 0 ? bf2f(rv[tok - 1]) : 0.f;
            fa[9] = s0 + 8 < L ? bf2f(r1[tok + 8]) : 0.f; fv[9] = s0 + 8 < L ? bf2f(rv[tok + 8]) : 0.f;
#pragma unroll
            for (int e = 0; e < 4; ++e) { fa[1 + 2 * e] = bf2f(xa[e] & 0xffffu); fa[2 + 2 * e] = bf2f(xa[e] >> 16); fv[1 + 2 * e] = bf2f(xv[e] & 0xffffu); fv[2 + 2 * e] = bf2f(xv[e] >> 16); }
            unsigned w[4];
#pragma unroll
            for (int e = 0; e < 4; ++e) { const float p0 = (vb + v0 * fv[2 * e] + v1 * fv[2 * e + 1] + v2 * fv[2 * e + 2]) * (ab + a0 * fa[2 * e] + a1 * fa[2 * e + 1] + a2 * fa[2 * e + 2]);
                const float p1 = (vb + v0 * fv[2 * e + 1] + v1 * fv[2 * e + 2] + v2 * fv[2 * e + 3]) * (ab + a0 * fa[2 * e + 1] + a1 * fa[2 * e + 2] + a2 * fa[2 * e + 3]); w[e] = pk2(p0, p1); }
            *(u32x4*)(lds + cc * C::CHB + C::VOFF + b * C::VBATCH + ((s0 >> 6) + C::ZB) * HY_BLK + 2 * (s0 & 63)) = (u32x4){w[0], w[1], w[2], w[3]}; }
        constexpr int NZ = NCH * NB * 2 * C::ZB * 9;
        for (int z = tid; z < NZ; z += 512) { const int cc = z / (NB * 2 * C::ZB * 9), rem = z - cc * (NB * 2 * C::ZB * 9), b = rem / (2 * C::ZB * 9), rr = rem - b * (2 * C::ZB * 9), blk = rr / 9, part = rr - blk * 9;
            *(u32x4*)(lds + cc * C::CHB + C::VOFF + b * C::VBATCH + (blk < C::ZB ? blk : L / 64 + blk) * HY_BLK + 16 * part) = (u32x4){0u, 0u, 0u, 0u}; }
    }
    __syncthreads();
    const int r = lane & 31, h = lane >> 5, sg = (4 - (r & 3)) & 3;
    const int cc = SAMPLE ? 0 : (wave >> 1), c = c0 + cc;
    const int I = SAMPLE ? 8 * wave + (r >> 2) : 2 * (wave & 1) + (r >> 4), b = SAMPLE ? (r & 3) : (r & 15);
    const int dlo = SAMPLE ? 8 * wave - 63 : 2 * (wave & 1) - 3, dhi = SAMPLE ? 8 * wave + 7 : 2 * (wave & 1) + 1;
    const float sinv = misc[cc], skip = a->in[I_SKIP][c];
    const unsigned char* chb = lds + cc * C::CHB;
    const unsigned char* abase = chb + sg * C::CPP + 2 * (L - r + 8 * h - sg);
    const unsigned char* bbase = chb + C::VOFF + b * C::VBATCH + (I + C::ZB) * HY_BLK + 16 * h;
    f32x16 acc0 = {}, acc1 = {};
    u32x2 W[6][2], Wn[4][2]; bf16x8 Bf[4], Bn[4];
    { const unsigned char* ap = abase - 32 * (4 * dlo - 3); const unsigned char* bp = bbase - HY_BLK * dlo;
#pragma unroll
      for (int k = 0; k < 2; ++k) { W[k][0] = *(const u32x2*)(ap - 32 * k); W[k][1] = *(const u32x2*)(ap - 32 * k + 8); }
#pragma unroll
      for (int k = 2; k < 6; ++k) { Wn[k - 2][0] = *(const u32x2*)(ap - 32 * k); Wn[k - 2][1] = *(const u32x2*)(ap - 32 * k + 8); }
#pragma unroll
      for (int kj = 0; kj < 4; ++kj) Bn[kj] = *(const bf16x8*)(bp + 32 * kj); }
#pragma unroll 1
    for (int d = dlo; d <= dhi; ++d) {
#pragma unroll
        for (int k = 0; k < 4; ++k) { W[k + 2][0] = Wn[k][0]; W[k + 2][1] = Wn[k][1]; Bf[k] = Bn[k]; }
        if (d < dhi) {
            const unsigned char* ap = abase - 32 * (4 * (d + 1) - 3); const unsigned char* bp = bbase - HY_BLK * (d + 1);
#pragma unroll
            for (int k = 2; k < 6; ++k) { Wn[k - 2][0] = *(const u32x2*)(ap - 32 * k); Wn[k - 2][1] = *(const u32x2*)(ap - 32 * k + 8); }
#pragma unroll
            for (int kj = 0; kj < 4; ++kj) Bn[kj] = *(const bf16x8*)(bp + 32 * kj);
        }
#pragma unroll
        for (int kj = 0; kj < 4; ++kj) {
            const bf16x8 A0 = __builtin_bit_cast(bf16x8, (u32x4){W[3 - kj][0].x, W[3 - kj][0].y, W[3 - kj][1].x, W[3 - kj][1].y});
            const bf16x8 A1 = __builtin_bit_cast(bf16x8, (u32x4){W[5 - kj][0].x, W[5 - kj][0].y, W[5 - kj][1].x, W[5 - kj][1].y});
            acc0 = __builtin_amdgcn_mfma_f32_32x32x16_bf16(A0, Bf[kj], acc0, 0, 0, 0);
            acc1 = __builtin_amdgcn_mfma_f32_32x32x16_bf16(A1, Bf[kj], acc1, 0, 0, 0);
        }
        W[0][0] = W[4][0]; W[0][1] = W[4][1]; W[1][0] = W[5][0]; W[1][1] = W[5][1];
    }
    {
        const bf16* r0 = UT + (size_t)c * NTOK + C::TOK0 + b * L; const bf16* rg = UT + (size_t)(1536 + c) * NTOK + C::TOK0 + b * L; bf16* yo = YT + (size_t)c * NTOK + C::TOK0 + b * L;
        const float x0w0 = cw[c], x0w1 = cw[1536 + c], x0w2 = cw[3072 + c], x0b = cb[c];
#pragma unroll
        for (int mi = 0; mi < 2; ++mi)
#pragma unroll
            for (int g = 0; g < 4; ++g) { const int i0 = 32 * mi + 8 * g + 4 * h, t0 = 64 * I + i0;
                const u32x2 vv = *(const u32x2*)(chb + C::VOFF + b * C::VBATCH + (I + C::ZB) * HY_BLK + 2 * i0);
                const u32x2 xx = *(const u32x2*)(r0 + t0), gg = *(const u32x2*)(rg + t0);
                float fx[6]; fx[0] = t0 > 0 ? bf2f(r0[t0 - 1]) : 0.f; fx[5] = t0 + 4 < L ? bf2f(r0[t0 + 4]) : 0.f;
                fx[1] = bf2f(xx.x & 0xffffu); fx[2] = bf2f(xx.x >> 16); fx[3] = bf2f(xx.y & 0xffffu); fx[4] = bf2f(xx.y >> 16);
                const float fvv[4] = {bf2f(vv.x & 0xffffu), bf2f(vv.x >> 16), bf2f(vv.y & 0xffffu), bf2f(vv.y >> 16)};
                const float fg[4] = {bf2f(gg.x & 0xffffu), bf2f(gg.x >> 16), bf2f(gg.y & 0xffffu), bf2f(gg.y >> 16)};
                float y[4];
#pragma unroll
                for (int e = 0; e < 4; ++e) { const float av = mi == 0 ? acc0[4 * g + e] : acc1[4 * g + e];
                    y[e] = (av * sinv + fvv[e] * skip) * (x0b + x0w0 * fx[e] + x0w1 * fx[e + 1] + x0w2 * fx[e + 2]) * fg[e]; }
                *(u32x2*)(yo + t0) = (u32x2){pk2(y[0], y[1]), pk2(y[2], y[3])}; }
    }
}

__device__ __forceinline__ int crow(int r, int hi) { return (r & 3) + 8 * (r >> 2) + 4 * hi; }
constexpr float ATT_THR = 8.0f;
constexpr int KS_PITCH = 104, VS_PITCH = 68;
constexpr int ATT_KS = 0, ATT_VS = 2 * 64 * KS_PITCH * 2, ATT_ST = ATT_VS + 2 * 64 * VS_PITCH * 2, ATT_ST_PITCH = 72;
template <bool FAST>
__device__ __forceinline__ bool attn_unit(ArgsP a, unsigned char* lds, int qrow0, int nact, int kvrow0, int Lk, int h, int lane, int wave) {
    asm volatile("" : "+v"(lane)); const int tid = wave * 64 + lane;
    const bf16* Q = (const bf16*)(a->ws + WS_Q); const bf16* KN = (const bf16*)(a->ws + WS_KN); const bf16* KR = (const bf16*)(a->ws + WS_KR);
    const bf16* VT = (const bf16*)(a->ws + WS_VT); const bf16* SGB = (const bf16*)(a->ws + WS_SGB); bf16* Z = (bf16*)(a->ws + WS_Z);
    bf16* Ks = (bf16*)(lds + ATT_KS); bf16* Vs = (bf16*)(lds + ATT_VS); bf16* St = (bf16*)(lds + ATT_ST) + wave * 32 * ATT_ST_PITCH;
    const int r32 = lane & 31, hi = lane >> 5; const bool act = wave < nact;
    bf16x8 qf[2][6];
    { const bf16* qp = Q + (size_t)(qrow0 + (act ? wave : 0) * 64 + r32) * 768 + h * 96 + 8 * hi;
#pragma unroll
        for (int qa = 0; qa < 2; ++qa)
#pragma unroll
            for (int ks = 0; ks < 6; ++ks) qf[qa][ks] = *(const bf16x8*)(qp + (size_t)qa * 32 * 768 + 16 * ks); }
    const int kkey = tid >> 3, kch = tid & 7;
    const int rkey = tid >> 2, rch = tid & 3;
    const int vd = tid >> 3, vch = tid & 7;
    const bf16* kn_src = KN + (size_t)(kvrow0 + kkey) * 512 + h * 64 + kch * 8;
    const bf16* kr_src = KR + (size_t)(kvrow0 + (rkey & 63)) * 32 + rch * 8;
    const bf16* vt_src = VT + (size_t)(h * 64 + vd) * NKV + kvrow0 + vch * 8;
    const int NT = Lk / 64;
    u32x4 kreg, rreg, vreg;
    kreg = *(const u32x4*)kn_src; rreg = (wave < 4) ? *(const u32x4*)kr_src : (u32x4){0u, 0u, 0u, 0u}; vreg = *(const u32x4*)vt_src;
    __syncthreads();
    { *(u32x4*)(Ks + kkey * KS_PITCH + kch * 8) = kreg; if (wave < 4) *(u32x4*)(Ks + rkey * KS_PITCH + 64 + rch * 8) = rreg;
      u32x2* vp = (u32x2*)(Vs + vd * VS_PITCH + vch * 8); vp[0] = (u32x2){vreg.x, vreg.y}; vp[1] = (u32x2){vreg.z, vreg.w}; }
    __syncthreads();
    float mhat[2] = {0.f, 0.f}, l_run[2] = {0.f, 0.f}; f32x16 o[2][2] = {};
#define ATT_TILE_MAX(j) do { \
        const int buf = j & 1; \
        if (j + 1 < NT) { kreg = *(const u32x4*)(kn_src + (size_t)(j + 1) * 64 * 512); if (wave < 4) rreg = *(const u32x4*)(kr_src + (size_t)(j + 1) * 64 * 32); vreg = *(const u32x4*)(vt_src + (j + 1) * 64); } \
        if (act) { \
            const bf16* kb = Ks + buf * 64 * KS_PITCH; const bf16* vb = Vs + buf * 64 * VS_PITCH; \
            f32x16 s[2][2]; \
        _Pragma("unroll") \
            for (int qa = 0; qa < 2; ++qa) { const float nm = -mhat[qa]; \
        _Pragma("unroll") \
                for (int r = 0; r < 16; ++r) { s[qa][0][r] = nm; s[qa][1][r] = nm; } } \
        _Pragma("unroll") \
            for (int ks = 0; ks < 6; ++ks) { const bf16x8 a0 = *(const bf16x8*)(kb + r32 * KS_PITCH + 16 * ks + 8 * hi), a1 = *(const bf16x8*)(kb + (32 + r32) * KS_PITCH + 16 * ks + 8 * hi); \
                s[0][0] = __builtin_amdgcn_mfma_f32_32x32x16_bf16(a0, qf[0][ks], s[0][0], 0, 0, 0); s[0][1] = __builtin_amdgcn_mfma_f32_32x32x16_bf16(a1, qf[0][ks], s[0][1], 0, 0, 0); \
                s[1][0] = __builtin_amdgcn_mfma_f32_32x32x16_bf16(a0, qf[1][ks], s[1][0], 0, 0, 0); s[1][1] = __builtin_amdgcn_mfma_f32_32x32x16_bf16(a1, qf[1][ks], s[1][1], 0, 0, 0); \
                asm volatile("" ::: "memory"); } \
            float mx[2]; \
        _Pragma("unroll") \
            for (int qa = 0; qa < 2; ++qa) { const f32x16& t0 = s[qa][0]; const f32x16& t1 = s[qa][1]; \
                float mxa = fmaxf(fmaxf(t0[0], t0[1]), t1[0]), mxb = fmaxf(fmaxf(t0[2], t0[3]), t1[1]); \
                mxa = fmaxf(fmaxf(mxa, t1[2]), t1[3]); \
        _Pragma("unroll") \
                for (int r = 4; r < 16; r += 4) { mxa = fmaxf(fmaxf(mxa, t0[r]), t0[r + 1]); mxb = fmaxf(fmaxf(mxb, t0[r + 2]), t0[r + 3]); mxa = fmaxf(fmaxf(mxa, t1[r]), t1[r + 1]); mxb = fmaxf(fmaxf(mxb, t1[r + 2]), t1[r + 3]); } \
                const float m1 = fmaxf(mxa, mxb); mx[qa] = fmaxf(m1, __shfl_xor(m1, 32)); } \
            const bool first = (j == 0); \
            if (first || __any(fmaxf(mx[0], mx[1]) > ATT_THR)) { \
                int hi2 = hi; asm volatile("" : "+v"(hi2)); \
        _Pragma("unroll") \
                for (int qa = 0; qa < 2; ++qa) { const float dl = first ? mx[qa] : fmaxf(mx[qa], 0.f); mhat[qa] += dl; \
        _Pragma("unroll") \
                    for (int r = 0; r < 16; ++r) { s[qa][0][r] -= dl; s[qa][1][r] -= dl; } \
                    if (!first) { const float alpha = __builtin_amdgcn_exp2f(-dl); l_run[qa] *= alpha; \
        _Pragma("unroll") \
                        for (int r = 0; r < 16; ++r) { const float ar = __shfl(alpha, crow(r, hi2)); o[qa][0][r] *= ar; o[qa][1][r] *= ar; } } } \
            } \
            bf16x8 pa[2][4]; \
        _Pragma("unroll") \
            for (int qa = 0; qa < 2; ++qa) { float ps = 0.f, ps2 = 0.f; \
        _Pragma("unroll") \
                for (int r = 0; r < 16; ++r) { s[qa][0][r] = __builtin_amdgcn_exp2f(s[qa][0][r]); s[qa][1][r] = __builtin_amdgcn_exp2f(s[qa][1][r]); ps += s[qa][0][r]; ps2 += s[qa][1][r]; } \
                l_run[qa] += ps + ps2; \
        _Pragma("unroll") \
                for (int s2 = 0; s2 < 2; ++s2) { \
                    u32x4 w0, w1; \
                    w0.x = pg8::cvt_pk_bf16(s[qa][0][8 * s2 + 0], s[qa][0][8 * s2 + 1]); w0.y = pg8::cvt_pk_bf16(s[qa][0][8 * s2 + 2], s[qa][0][8 * s2 + 3]); w0.z = pg8::cvt_pk_bf16(s[qa][0][8 * s2 + 4], s[qa][0][8 * s2 + 5]); w0.w = pg8::cvt_pk_bf16(s[qa][0][8 * s2 + 6], s[qa][0][8 * s2 + 7]); \
                    w1.x = pg8::cvt_pk_bf16(s[qa][1][8 * s2 + 0], s[qa][1][8 * s2 + 1]); w1.y = pg8::cvt_pk_bf16(s[qa][1][8 * s2 + 2], s[qa][1][8 * s2 + 3]); w1.z = pg8::cvt_pk_bf16(s[qa][1][8 * s2 + 4], s[qa][1][8 * s2 + 5]); w1.w = pg8::cvt_pk_bf16(s[qa][1][8 * s2 + 6], s[qa][1][8 * s2 + 7]); \
                    pa[qa][s2] = __builtin_bit_cast(bf16x8, w0); pa[qa][2 + s2] = __builtin_bit_cast(bf16x8, w1); } } \
        _Pragma("unroll") \
            for (int kk = 0; kk < 4; ++kk) { \
                const int base = 16 * kk + 4 * hi; \
                const u32x2 l0 = *(const u32x2*)(vb + r32 * VS_PITCH + base), h0 = *(const u32x2*)(vb + r32 * VS_PITCH + base + 8); \
                const u32x2 l1 = *(const u32x2*)(vb + (32 + r32) * VS_PITCH + base), h1 = *(const u32x2*)(vb + (32 + r32) * VS_PITCH + base + 8); \
                const bf16x8 vf0 = __builtin_bit_cast(bf16x8, (u32x4){l0.x, l0.y, h0.x, h0.y}), vf1 = __builtin_bit_cast(bf16x8, (u32x4){l1.x, l1.y, h1.x, h1.y}); \
                o[0][0] = __builtin_amdgcn_mfma_f32_32x32x16_bf16(pa[0][kk], vf0, o[0][0], 0, 0, 0); o[0][1] = __builtin_amdgcn_mfma_f32_32x32x16_bf16(pa[0][kk], vf1, o[0][1], 0, 0, 0); \
                o[1][0] = __builtin_amdgcn_mfma_f32_32x32x16_bf16(pa[1][kk], vf0, o[1][0], 0, 0, 0); o[1][1] = __builtin_amdgcn_mfma_f32_32x32x16_bf16(pa[1][kk], vf1, o[1][1], 0, 0, 0); \
                asm volatile("" ::: "memory"); \
            } \
        } \
        if (j + 1 < NT) { bf16* kd = Ks + (buf ^ 1) * 64 * KS_PITCH; bf16* vd2 = Vs + (buf ^ 1) * 64 * VS_PITCH; \
            *(u32x4*)(kd + kkey * KS_PITCH + kch * 8) = kreg; if (wave < 4) *(u32x4*)(kd + rkey * KS_PITCH + 64 + rch * 8) = rreg; \
            u32x2* vp = (u32x2*)(vd2 + vd * VS_PITCH + vch * 8); vp[0] = (u32x2){vreg.x, vreg.y}; vp[1] = (u32x2){vreg.z, vreg.w}; } \
        __syncthreads(); \
    } while (0)
#define ATT_TILE_FAST(j) do { \
        const int buf = j & 1; \
        if (j + 1 < NT) { kreg = *(const u32x4*)(kn_src + (size_t)(j + 1) * 64 * 512); if (wave < 4) rreg = *(const u32x4*)(kr_src + (size_t)(j + 1) * 64 * 32); vreg = *(const u32x4*)(vt_src + (j + 1) * 64); } \
        if (act) { \
            const bf16* kb = Ks + buf * 64 * KS_PITCH; const bf16* vb = Vs + buf * 64 * VS_PITCH; \
            f32x16 s[2][2] = {}; \
            bf16x8 ka[3][2]; \
        _Pragma("unroll") \
            for (int ks = 0; ks < 2; ++ks) { ka[ks][0] = *(const bf16x8*)(kb + r32 * KS_PITCH + 16 * ks + 8 * hi); ka[ks][1] = *(const bf16x8*)(kb + (32 + r32) * KS_PITCH + 16 * ks + 8 * hi); } \
        _Pragma("unroll") \
            for (int ks = 0; ks < 6; ++ks) { \
                if (ks + 2 < 6) { ka[(ks + 2) % 3][0] = *(const bf16x8*)(kb + r32 * KS_PITCH + 16 * (ks + 2) + 8 * hi); ka[(ks + 2) % 3][1] = *(const bf16x8*)(kb + (32 + r32) * KS_PITCH + 16 * (ks + 2) + 8 * hi); } \
                const bf16x8 a0 = ka[ks % 3][0], a1 = ka[ks % 3][1]; \
                s[0][0] = __builtin_amdgcn_mfma_f32_32x32x16_bf16(a0, qf[0][ks], s[0][0], 0, 0, 0); s[0][1] = __builtin_amdgcn_mfma_f32_32x32x16_bf16(a1, qf[0][ks], s[0][1], 0, 0, 0); \
                s[1][0] = __builtin_amdgcn_mfma_f32_32x32x16_bf16(a0, qf[1][ks], s[1][0], 0, 0, 0); s[1][1] = __builtin_amdgcn_mfma_f32_32x32x16_bf16(a1, qf[1][ks], s[1][1], 0, 0, 0); \
                } \
            bf16x8 pa[2][4]; \
        _Pragma("unroll") \
            for (int qa = 0; qa < 2; ++qa) { float ps = 0.f, ps2 = 0.f; \
        _Pragma("unroll") \
                for (int r = 0; r < 16; ++r) { s[qa][0][r] = __builtin_amdgcn_exp2f(s[qa][0][r]); s[qa][1][r] = __builtin_amdgcn_exp2f(s[qa][1][r]); ps += s[qa][0][r]; ps2 += s[qa][1][r]; } \
                l_run[qa] += ps + ps2; \
        _Pragma("unroll") \
                for (int s2 = 0; s2 < 2; ++s2) { \
                    u32x4 w0, w1; \
                    w0.x = pg8::cvt_pk_bf16(s[qa][0][8 * s2 + 0], s[qa][0][8 * s2 + 1]); w0.y = pg8::cvt_pk_bf16(s[qa][0][8 * s2 + 2], s[qa][0][8 * s2 + 3]); w0.z = pg8::cvt_pk_bf16(s[qa][0][8 * s2 + 4], s[qa][0][8 * s2 + 5]); w0.w = pg8::cvt_pk_bf16(s[qa][0][8 * s2 + 6], s[qa][0][8 * s2 + 7]); \
                    w1.x = pg8::cvt_pk_bf16(s[qa][1][8 * s2 + 0], s[qa][1][8 * s2 + 1]); w1.y = pg8::cvt_pk_bf16(s[qa][1][8 * s2 + 2], s[qa][1][8 * s2 + 3]); w1.z = pg8::cvt_pk_bf16(s[qa][1][8 * s2 + 4], s[qa][1][8 * s2 + 5]); w1.w = pg8::cvt_pk_bf16(s[qa][1][8 * s2 + 6], s[qa][1][8 * s2 + 7]); \
                    pa[qa][s2] = __builtin_bit_cast(bf16x8, w0); pa[qa][2 + s2] = __builtin_bit_cast(bf16x8, w1); } } \
        _Pragma("unroll") \
            for (int kk = 0; kk < 4; ++kk) { \
                const int base = 16 * kk + 4 * hi; \
                const u32x2 l0 = *(const u32x2*)(vb + r32 * VS_PITCH + base), h0 = *(const u32x2*)(vb + r32 * VS_PITCH + base + 8); \
                const u32x2 l1 = *(const u32x2*)(vb + (32 + r32) * VS_PITCH + base), h1 = *(const u32x2*)(vb + (32 + r32) * VS_PITCH + base + 8); \
                const bf16x8 vf0 = __builtin_bit_cast(bf16x8, (u32x4){l0.x, l0.y, h0.x, h0.y}), vf1 = __builtin_bit_cast(bf16x8, (u32x4){l1.x, l1.y, h1.x, h1.y}); \
                o[0][0] = __builtin_amdgcn_mfma_f32_32x32x16_bf16(pa[0][kk], vf0, o[0][0], 0, 0, 0); o[0][1] = __builtin_amdgcn_mfma_f32_32x32x16_bf16(pa[0][kk], vf1, o[0][1], 0, 0, 0); \
                o[1][0] = __builtin_amdgcn_mfma_f32_32x32x16_bf16(pa[1][kk], vf0, o[1][0], 0, 0, 0); o[1][1] = __builtin_amdgcn_mfma_f32_32x32x16_bf16(pa[1][kk], vf1, o[1][1], 0, 0, 0); \
                \
            } \
        } \
        if (j + 1 < NT) { bf16* kd = Ks + (buf ^ 1) * 64 * KS_PITCH; bf16* vd2 = Vs + (buf ^ 1) * 64 * VS_PITCH; \
            *(u32x4*)(kd + kkey * KS_PITCH + kch * 8) = kreg; if (wave < 4) *(u32x4*)(kd + rkey * KS_PITCH + 64 + rch * 8) = rreg; \
            u32x2* vp = (u32x2*)(vd2 + vd * VS_PITCH + vch * 8); vp[0] = (u32x2){vreg.x, vreg.y}; vp[1] = (u32x2){vreg.z, vreg.w}; } \
        __syncthreads(); \
    } while (0)
    if (FAST) {
#pragma unroll 1
        for (int j = 0; j < NT; ++j) ATT_TILE_FAST(j);
    } else {
#pragma unroll 1
        for (int j = 0; j < NT; ++j) ATT_TILE_MAX(j);
    }
#undef ATT_TILE_MAX
#undef ATT_TILE_FAST
    bool bad = false;
    if (act) {
        int lane3 = lane; asm volatile("" : "+v"(lane3)); const int r32e = lane3 & 31, hie = lane3 >> 5;
#pragma unroll
        for (int qa = 0; qa < 2; ++qa) {
            const float lt = l_run[qa] + __shfl_xor(l_run[qa], 32); const float inv = 1.0f / lt; bad |= !(lt > 1e-30f && lt < 1e30f);
#pragma unroll
            for (int r = 0; r < 16; ++r) { const int q = crow(r, hie); const float ir = __shfl(inv, q);
                St[q * ATT_ST_PITCH + r32e] = (bf16)f2bf(o[qa][0][r] * ir); St[q * ATT_ST_PITCH + 32 + r32e] = (bf16)f2bf(o[qa][1][r] * ir); }
            __builtin_amdgcn_s_waitcnt(0xc07f); asm volatile("" ::: "memory");
#pragma unroll
            for (int it = 0; it < 4; ++it) { const int q = it * 8 + (lane3 >> 3), ch = lane3 & 7; const int row = qrow0 + wave * 64 + qa * 32 + q;
                const u32x4 ov = *(const u32x4*)(St + q * ATT_ST_PITCH + ch * 8); const u32x4 gv = __builtin_nontemporal_load((const u32x4*)(SGB + (size_t)row * 512 + h * 64 + ch * 8));
                u32x4 res;
#pragma unroll
                for (int e = 0; e < 4; ++e) { const unsigned ow = ov[e], gw = gv[e];
                    res[e] = pk2(bf2f(ow & 0xffffu) * bf2f(gw & 0xffffu), bf2f(ow >> 16) * bf2f(gw >> 16)); }
                *(u32x4*)(Z + (size_t)row * DM + 512 + h * 64 + ch * 8) = res; }
            __builtin_amdgcn_s_waitcnt(0xc07f); asm volatile("" ::: "memory");
        }
    }
    if (!FAST) return false;
    volatile LAS unsigned* cwl = (volatile LAS unsigned*)((LAS unsigned char*)g_lds + CTXW_OFF);
    if (__any(bad) && lane == 0) cwl[71] = 1u;
    __syncthreads();
    const bool anybad = __builtin_amdgcn_readfirstlane((int)cwl[71]) != 0;
    __syncthreads();
    if (wave == 0 && lane == 0) cwl[71] = 0u;
    return anybad;
}
__device__ __forceinline__ void attn_phase(ArgsP a, unsigned char* lds, int tid, int lane, int wave, int vcu, int G) {
    for (int su = vcu; su < 256; su += G) { const int b = su >> 6, h = (su >> 3) & 7, qb = su & 7;
        if (attn_unit<true>(a, lds, NPR + b * LSM + qb * 512, 8, NPR + b * LKS, LKS, h, lane, wave)) attn_unit<false>(a, lds, NPR + b * LSM + qb * 512, 8, NPR + b * LKS, LKS, h, lane, wave); }
    for (int pu = vcu; pu < 128; pu += G) { const int b = pu >> 3, h = pu & 7;
        if (attn_unit<true>(a, lds, b * LPR, 4, b * LPR, LPR, h, lane, wave)) attn_unit<false>(a, lds, b * LPR, 4, b * LPR, LPR, h, lane, wave); }
}
__device__ __forceinline__ void transpose_yt_phase(ArgsP a, unsigned char* lds, int lane, int wave, int bid, int G) {
    const bf16* YT = (const bf16*)(a->ws + WS_YT); bf16* Z = (bf16*)(a->ws + WS_Z);
    bf16* scr = (bf16*)lds + wave * (64 * 66);
    const int vcu_ = (G % 8 == 0) ? (bid % 8) * (G / 8) + bid / 8 : bid; const bool half_ = (G == 256);
    const int gw = half_ ? (vcu_ - 128) * NWAVES + wave : bid * NWAVES + wave, NGW = half_ ? 128 * NWAVES : G * NWAVES;
    __syncthreads();
    for (int it = (gw >= 0 ? gw : 8 * 320); it < 8 * 320; it += NGW) { const int c0 = (it & 7) * 64, t0 = (it >> 3) * 64;
#pragma unroll
        for (int i = 0; i < 8; ++i) { const int c = i * 8 + (lane >> 3), ch = lane & 7; const u32x4 v = __builtin_nontemporal_load((const u32x4*)(YT + (size_t)(c0 + c) * NTOK + t0 + ch * 8));
#pragma unroll
            for (int e = 0; e < 4; ++e) { scr[(ch * 8 + 2 * e) * 66 + c] = (bf16)(v[e] & 0xffffu); scr[(ch * 8 + 2 * e + 1) * 66 + c] = (bf16)(v[e] >> 16); } }
        __builtin_amdgcn_s_waitcnt(0xc07f); asm volatile("" ::: "memory");
#pragma unroll
        for (int i = 0; i < 8; ++i) { const int t = i * 8 + (lane >> 3), ch = lane & 7; const unsigned* sp = (const unsigned*)(scr + t * 66 + ch * 8);
            u32x4 o; o.x = sp[0]; o.y = sp[1]; o.z = sp[2]; o.w = sp[3]; *(u32x4*)(Z + (size_t)(t0 + t) * DM + c0 + ch * 8) = o; }
        __builtin_amdgcn_s_waitcnt(0xc07f); asm volatile("" ::: "memory");
    }
}

constexpr int DX_PITCH = 576, DF_PITCH = 272, DS_PITCH = 528;
constexpr int DX_OFF = 0, DF_OFF = 128 * DX_PITCH;
typedef short v4i16_t __attribute__((ext_vector_type(4)));
__device__ __forceinline__ v4i16_t lds_tr16(const unsigned char* p) { return __builtin_amdgcn_ds_read_tr16_b64_v4i16((__attribute__((address_space(3))) v4i16_t*)(uintptr_t)p); }
template <class RowPtr> __device__ __forceinline__ void dft_issue_x(u32x4 (&v)[8], int tid, const RowPtr& rp) {
    asm volatile("" : "+v"(tid));
#pragma unroll
    for (int i = 0; i < 8; ++i) { const int id = tid + 512 * i, row = id >> 5, c16 = id & 31; v[i] = __builtin_nontemporal_load((const u32x4*)(rp(row) + 8 * c16)); }
}
__device__ __forceinline__ void dft_commit_x(unsigned char* lds, const u32x4 (&v)[8], int tid) {
    asm volatile("" : "+v"(tid));
#pragma unroll
    for (int i = 0; i < 8; ++i) { const int id = tid + 512 * i, row = id >> 5, c16 = id & 31; *(u32x4*)(lds + DX_OFF + row * DX_PITCH + 16 * c16) = v[i]; }
}
template <int MB> __device__ __forceinline__ void dft_mma(f32x16 (&acc)[MB], const unsigned char* lds, int lane, int wave) {
    asm volatile("" : "+v"(lane));
    const int r = lane & 31, h = lane >> 5, g = lane >> 4, q = (lane >> 2) & 3, p = lane & 3;
    const unsigned char* ap = lds + DX_OFF + (8 * h + q) * DX_PITCH + (wave * 32 + 16 * (g & 1) + 4 * p) * 2;
    const unsigned char* bp = lds + DF_OFF + r * DF_PITCH + 16 * h;
#pragma unroll
    for (int ks = 0; ks < 8; ++ks) {
        const v4i16_t lo = lds_tr16(ap + ks * 16 * DX_PITCH), hi4 = lds_tr16(ap + ks * 16 * DX_PITCH + 4 * DX_PITCH);
        const bf16x8 A = (bf16x8){lo[0], lo[1], lo[2], lo[3], hi4[0], hi4[1], hi4[2], hi4[3]};
#pragma unroll
        for (int mb = 0; mb < MB; ++mb) { const bf16x8 B = *(const bf16x8*)(bp + mb * 32 * DF_PITCH + 32 * ks); acc[mb] = __builtin_amdgcn_mfma_f32_32x32x16_bf16(A, B, acc[mb], 0, 0, 0); }
        if (ks & 1) asm volatile("" ::: "memory");
    }
}
template <int MB> __device__ __forceinline__ void dft_stage(const f32x16 (&acc)[MB], unsigned char* lds, int lane, int wave, float scale) {
    asm volatile("" : "+v"(lane));
    const int r = lane & 31, h = lane >> 5;
#pragma unroll
    for (int mb = 0; mb < MB; ++mb)
#pragma unroll
        for (int g4 = 0; g4 < 4; ++g4) { u32x2 w; w.x = pk2(acc[mb][4 * g4] * scale, acc[mb][4 * g4 + 1] * scale); w.y = pk2(acc[mb][4 * g4 + 2] * scale, acc[mb][4 * g4 + 3] * scale);
            *(u32x2*)(lds + DX_OFF + (mb * 32 + r) * DS_PITCH + (wave * 32 + 8 * g4 + 4 * h) * 2) = w; }
}
template <int MB, bool GATE, class OutPtr, class GatePtr> __device__ __forceinline__ void dft_write(const unsigned char* lds, int tid, const OutPtr& op, const GatePtr& gp) {
    asm volatile("" : "+v"(tid));
#pragma unroll
    for (int i = 0; i < MB * 2; ++i) { const int id = tid + 512 * i, m = id >> 5, c16 = id & 31; u32x4 v = *(const u32x4*)(lds + DX_OFF + m * DS_PITCH + 16 * c16);
        if (GATE) { const u32x4 gv = __builtin_nontemporal_load((const u32x4*)(gp(m) + 8 * c16));
#pragma unroll
            for (int e = 0; e < 4; ++e) v[e] = pk2(bf2f(v[e] & 0xffffu) * bf2f(gv[e] & 0xffffu), bf2f(v[e] >> 16) * bf2f(gv[e] >> 16)); }
        *(u32x4*)(op(m) + 8 * c16) = v; }
}
struct NoGate { __device__ __forceinline__ const bf16* operator()(int) const { return nullptr; } };

__device__ __forceinline__ void dft_stage1_phase(ArgsP a, unsigned char* lds, int tid, int lane, int wave, int bid, int G) {
    const bf16* A = (const bf16*)(a->ws + WS_A); const bf16* B = (const bf16*)(a->ws + WS_B); bf16* TR = (bf16*)(a->ws + WS_TR); bf16* TI = (bf16*)(a->ws + WS_TI);
    const float* TW = (const float*)(a->ws + WS_TW);
#pragma unroll 1
    for (int unit = bid; unit < 256; unit += G) { const int b = unit >> 6, n2 = unit & 63;
        u32x4 xv[8];
        auto rp1 = [&](int chunk) { return [=](int row) { const int part = row >> 6, n1 = row & 63; return (part ? B : A) + (size_t)(NPR + b * LSM + 64 * n1 + n2) * DM + chunk * 256; }; };
        dft_issue_x(xv, tid, rp1(0));
        __syncthreads();
        { float* tab = (float*)(lds + DX_OFF);
#pragma unroll
          for (int i = 0; i < 4; ++i) { const int id = tid + 512 * i; *(f32x4*)(tab + 4 * id) = *(const f32x4*)(TW + 4 * id); } }
        __syncthreads();
        { const float* tab = (const float*)(lds + DX_OFF);
          const int m = tid >> 2, po = m >> 6, k1 = m & 63, kq = tid & 3, pi = kq >> 1;
#pragma unroll
          for (int c8 = 0; c8 < 4; ++c8) { unsigned w[4];
#pragma unroll
              for (int e2 = 0; e2 < 4; ++e2) { float vv[2];
#pragma unroll
                  for (int t = 0; t < 2; ++t) { const int n1 = (kq & 1) * 32 + c8 * 8 + e2 * 2 + t; const int idx = (k1 * (64 * n1 + n2)) & 4095; const float cs = tab[2 * idx], sn = tab[2 * idx + 1];
                      vv[t] = po == 0 ? (pi == 0 ? cs : -sn) : (pi == 0 ? -sn : -cs); }
                  w[e2] = pk2(vv[0], vv[1]); }
              *(u32x4*)(lds + DF_OFF + m * DF_PITCH + (kq * 32 + c8 * 8) * 2) = (u32x4){w[0], w[1], w[2], w[3]}; } }
#pragma unroll 1
        for (int chunk = 0; chunk < 4; ++chunk) {
            __syncthreads();
            dft_commit_x(lds, xv, tid);
            if (chunk + 1 < 4) dft_issue_x(xv, tid, rp1(chunk + 1));
            __syncthreads();
            f32x16 acc[4] = {};
            dft_mma<4>(acc, lds, lane, wave);
            __syncthreads();
            dft_stage<4>(acc, lds, lane, wave, 1.0f);
            __syncthreads();
            dft_write<4, false>(lds, tid, [&](int m) { const int po = m >> 6, k1 = m & 63; return (po ? TI : TR) + ((size_t)((b * 64 + k1) * 64 + n2)) * DM + chunk * 256; }, NoGate());
        }
    }
    __syncthreads();
}
__device__ __forceinline__ void dft_stage2_phase(ArgsP a, unsigned char* lds, int tid, int lane, int wave, int first, int stride) {
    const bf16* TR = (const bf16*)(a->ws + WS_TR); const bf16* TI = (const bf16*)(a->ws + WS_TI); const bf16* SG = (const bf16*)(a->ws + WS_SG); bf16* Z2 = (bf16*)(a->ws + WS_Z2);
    const float* TW64 = (const float*)(a->ws + WS_TW) + 2 * (4096 + 256);
    __syncthreads();
    {
      const int m = tid >> 3, k0 = (tid & 7) * 16, pi = k0 >> 6;
#pragma unroll
      for (int c8 = 0; c8 < 2; ++c8) { unsigned w[4];
#pragma unroll
          for (int e2 = 0; e2 < 4; ++e2) { float vv[2];
#pragma unroll
              for (int t = 0; t < 2; ++t) { const int n2 = (k0 & 63) + c8 * 8 + e2 * 2 + t; const int idx = (m * n2) & 63; vv[t] = pi == 0 ? TW64[2 * idx] : TW64[2 * idx + 1]; }
              w[e2] = pk2(vv[0], vv[1]); }
          *(u32x4*)(lds + DF_OFF + m * DF_PITCH + (k0 + c8 * 8) * 2) = (u32x4){w[0], w[1], w[2], w[3]}; } }
#pragma unroll 1
    for (int hu = first; hu < 512; hu += stride) { const int unit = hu >> 1, cb0 = 2 * (hu & 1), b = unit >> 6, k1 = unit & 63;
        u32x4 xv[8];
        auto rp2 = [&](int chunk) { return [=](int row) { const int part = row >> 6, n2 = row & 63; return (part ? TI : TR) + ((size_t)((b * 64 + k1) * 64 + n2)) * DM + chunk * 256; }; };
        dft_issue_x(xv, tid, rp2(cb0));
#pragma unroll 1
        for (int chunk = cb0; chunk < cb0 + 2; ++chunk) {
            __syncthreads();
            dft_commit_x(lds, xv, tid);
            if (chunk + 1 < cb0 + 2) dft_issue_x(xv, tid, rp2(chunk + 1));
            __syncthreads();
            f32x16 acc[2] = {};
            dft_mma<2>(acc, lds, lane, wave);
            __syncthreads();
            dft_stage<2>(acc, lds, lane, wave, 0.015625f);
            __syncthreads();
            dft_write<2, true>(lds, tid, [&](int m) { return Z2 + (size_t)(NPR + b * LSM + k1 + 64 * m) * DM + chunk * 256; }, [&](int m) { return SG + (size_t)(NPR + b * LSM + k1 + 64 * m) * DM + chunk * 256; });
        }
    }
    __syncthreads();
}
constexpr int DTW_OFF = DF_OFF + 128 * DF_PITCH;
__device__ __forceinline__ void dft_prompt_phase(ArgsP a, unsigned char* lds, int tid, int lane, int wave, int bid, int G) {
    const bf16* A = (const bf16*)(a->ws + WS_A); const bf16* B = (const bf16*)(a->ws + WS_B); const bf16* SG = (const bf16*)(a->ws + WS_SG); bf16* Z2 = (bf16*)(a->ws + WS_Z2);
    __syncthreads();
    { const float* TW256 = (const float*)(a->ws + WS_TW) + 2 * 4096; ((float*)(lds + DTW_OFF))[tid] = TW256[tid]; }
    const float* tw = (const float*)(lds + DTW_OFF);
#pragma unroll 1
    for (int unit = bid; unit < 256; unit += G) { const int b = unit >> 4, q4 = (unit >> 2) & 3, chunk = unit & 3;
        f32x16 acc[2] = {};
        u32x4 xv[8];
        auto rpp = [&](int pc) { return [=](int row) { const int part = row >> 6, l = 64 * pc + (row & 63); return (part ? B : A) + (size_t)(b * LPR + l) * DM + chunk * 256; }; };
        dft_issue_x(xv, tid, rpp(0));
#pragma unroll 1
        for (int pc = 0; pc < 4; ++pc) {
            __syncthreads();
            {
              const int m = tid >> 3, lp = 64 * q4 + m, k0 = (tid & 7) * 16, pi = k0 >> 6;
#pragma unroll
              for (int c8 = 0; c8 < 2; ++c8) { unsigned w[4];
#pragma unroll
                  for (int e2 = 0; e2 < 4; ++e2) { float vv[2];
#pragma unroll
                      for (int t = 0; t < 2; ++t) { const int l = 64 * pc + (k0 & 63) + c8 * 8 + e2 * 2 + t; const int idx = (l * lp) & 255; vv[t] = pi == 0 ? tw[2 * idx] : -tw[2 * idx + 1]; }
                      w[e2] = pk2(vv[0], vv[1]); }
                  *(u32x4*)(lds + DF_OFF + m * DF_PITCH + (k0 + c8 * 8) * 2) = (u32x4){w[0], w[1], w[2], w[3]}; } }
            dft_commit_x(lds, xv, tid);
            if (pc + 1 < 4) dft_issue_x(xv, tid, rpp(pc + 1));
            __syncthreads();
            dft_mma<2>(acc, lds, lane, wave);
        }
        __syncthreads();
        dft_stage<2>(acc, lds, lane, wave, 0.0625f);
        __syncthreads();
        dft_write<2, true>(lds, tid, [&](int m) { return Z2 + (size_t)(b * LPR + 64 * q4 + m) * DM + chunk * 256; }, [&](int m) { return SG + (size_t)(b * LPR + 64 * q4 + m) * DM + chunk * 256; });
    }
    __syncthreads();
}

constexpr int NPHASE = 12;
#define PH_CTX const Ctx cx_ = get_ctx(); ArgsP A = cx_.a; const int G = A->grid, bid = cx_.bid; const int wave = cx_.wave, lane = LANE_ID(), tid = wave * 64 + lane; (void)tid; \
    unsigned char* const ws = A->ws; (void)G; (void)bid; (void)lane; (void)wave; (void)ws
__device__ __forceinline__ bool ph_in(int k) { const Ctx cx_ = get_ctx(); return cx_.a->ph_lo <= k && k < cx_.a->ph_hi; }
__device__ __forceinline__ void ph_seam(int k, unsigned char* lds) {
    const Ctx cx_ = get_ctx(); ArgsP A = cx_.a; const int wave_s = cx_.wave;
    if (A->ph_lo <= k && k + 1 <= A->ph_hi - 1) { XcdBarrier bar; bar.bar = (unsigned*)((gu32*)(A->ws + WS_CTL) + CW_BAR); bar.x = xb_xcc_id(); bar.st = (volatile LAS unsigned*)((LAS unsigned char*)lds + MISC_OFF) + 8; xcd_barrier(bar, wave_s == 0 && __builtin_amdgcn_mbcnt_hi(~0u, __builtin_amdgcn_mbcnt_lo(~0u, 0u)) == 0u); }
}
__global__ void __launch_bounds__(NWAVES * 64, 2) fwd_kernel(Args args_unused_directly) {
    unsigned char* const lds = g_lds;
    {
        const int wave0 = __builtin_amdgcn_readfirstlane((int)threadIdx.x >> 6), lane0 = LANE_ID(), tid0 = wave0 * 64 + lane0;
        LAS unsigned* cw = (LAS unsigned*)((LAS unsigned char*)lds + LDSCTL_OFF);
        for (int u = tid0; u < (LDS_BYTES - LDSCTL_OFF) / 4; u += NWAVES * 64) cw[u] = 0u;
        __syncthreads();
        const unsigned long long kp = (unsigned long long)(uintptr_t)__builtin_amdgcn_kernarg_segment_ptr();
        if (lane0 == 0) cw[hw_slot()] = (unsigned)wave0;
        if (tid0 == 0) cw[71] = 0u;
        if (tid0 == 0) { cw[64] = blockIdx.x; cw[66] = (unsigned)kp; cw[67] = (unsigned)(kp >> 32); }
        __syncthreads();
        ArgsP A = (ArgsP)__builtin_amdgcn_kernarg_segment_ptr();
        if (cw[hw_slot()] != (unsigned)wave0 && lane0 == 0) A->out[0] = __builtin_nanf("");
        if (A->ph_hi - A->ph_lo > 1) (void)xcd_barrier_post((unsigned*)((gu32*)(A->ws + WS_CTL) + CW_BAR), (volatile LAS unsigned*)((LAS unsigned char*)lds + MISC_OFF) + 8, tid0 == 0);
    }
#ifndef PH_MASK
#define PH_MASK 0xFFF
#endif
#define IN(k) ((((PH_MASK) >> (k)) & 1) && ph_in(k))
#ifndef REP_SEAM
#define REP_SEAM 1
#endif
#ifdef TSK
#define STAMP(i) do { const Ctx cs_ = get_ctx(); if (cs_.bid == 0 && cs_.wave == 0 && LANE_ID() == 0) { const unsigned long long t_ = __builtin_amdgcn_s_memrealtime(); \
    volatile LAS unsigned* w_ = (volatile LAS unsigned*)((LAS unsigned char*)g_lds + CTXW_OFF); w_[100 + 2 * (i)] = (unsigned)t_; w_[101 + 2 * (i)] = (unsigned)(t_ >> 32); \
    const unsigned long long c_ = __builtin_amdgcn_s_memtime(); w_[140 + 2 * (i)] = (unsigned)c_; w_[141 + 2 * (i)] = (unsigned)(c_ >> 32); } } while (0)
#else
#define STAMP(i) do { } while (0)
#endif
#define SEAM(k) do { for (int rs_ = 0; rs_ < REP_SEAM; ++rs_) ph_seam(k, lds); STAMP((k) + 1); } while (0)
#define BF(off) ((pg8::bf16_t*)(ws + (off)))
#define RING ((PG8_LAS unsigned char*)lds)

#ifndef REP_P0
#define REP_P0 1
#endif
    STAMP(0);
    if (IN(0)) { drain_segment(lds, 0); }
    SEAM(1);
#ifndef REP_P2
#define REP_P2 1
#endif
    if (IN(2)) for (int rep2 = 0; rep2 < REP_P2; ++rep2) {
        PH_CTX; pg8::Gemm g{BF(WS_WT_IN_E), BF(WS_H), 2048, NTOK, 1024, BF(WS_H), BF(WS_WT_IN_E) + (size_t)2048 * 1024};
        pg8::TwoOrder S; S.init(2048, NTOK, NTOK, 1024, G, bid);
        pg8::EpiP2 E{pg8::EpiP2a{ws}, pg8::EpiP2b{ws, A->out, A->in[I_QG], A->in[I_KVG]}};
        pg8::gemm_phase<pg8::EpiP2, pg8::TwoOrder, true, true>(RING, g, S, E, wave);
    }
#ifdef EXP_S1_AFTER
    SEAM(2);
    if (IN(2)) drain_segment(lds, 1);
    STAMP(20); ph_seam(2, lds);
#else
    if (IN(2)) drain_segment(lds, 1);
    SEAM(2);
#endif
    if (IN(3)) {
#ifndef NO_P3Q
        { PH_CTX; int K3 = 256; asm volatile("" : "+s"(K3));
          pg8::Gemm g{BF(WS_CQ), BF(WS_WT_UQ), NTOK, 768, K3}; pg8::StaticOrder S; S.init(NTOK, 768, G, bid);
          pg8::EpiP3q E{ws};
          pg8::gemm_phase<pg8::EpiP3q, pg8::StaticOrder, true, true>(RING, g, S, E, wave); }
#endif
#ifndef NO_P3K
        { PH_CTX; int K3 = 256; asm volatile("" : "+s"(K3));
          pg8::Gemm g{BF(WS_CKV), BF(WS_WT_UK), NKV, 512, K3}; pg8::StaticOrder S; S.init(NKV, 512, G, bid);
          pg8::EpiP3k E{ws};
          pg8::gemm_phase<pg8::EpiP3k, pg8::StaticOrder, true, true>(RING, g, S, E, wave); }
#endif
#ifndef NO_P3V
        { PH_CTX; int K3 = 256; asm volatile("" : "+s"(K3));
          pg8::Gemm g{BF(WS_WT_UV), BF(WS_CKV), 512, NKV, K3}; pg8::StaticOrder S; S.init(512, NKV, G, (bid + 176) % G);
          pg8::EpiP3v E{ws};
          pg8::gemm_phase<pg8::EpiP3v, pg8::StaticOrder, true, true>(RING, g, S, E, wave); }
#endif
        { PH_CTX; state_fix_phase(A, tid, bid, G);
#ifndef NO_HYENA
#ifndef REP_HYENA
#define REP_HYENA 1
#endif
          for (int rep = 0; rep < REP_HYENA; ++rep)
          for (int u = bid; u < 512; u += G) hyena_mfma_unit<true>(A, lds, u, tid, lane, wave);
          { const int pu = bid < 80 ? bid : (bid >= 176 ? bid - 96 : -1);
            if (pu >= 0 && pu < 128) hyena_mfma_unit<false>(A, lds, pu, tid, lane, wave); }
#endif
          __syncthreads(); }
    }
    if (IN(3)) drain_segment(lds, 2);
    SEAM(3);
    if (IN(4)) { PH_CTX; const int vcu = (G % 8 == 0) ? (bid % 8) * (G / 8) + bid / 8 : bid;
#ifndef NO_ATTN
#ifndef REP_ATTN
#define REP_ATTN 1
#endif
        for (int rep = 0; rep < REP_ATTN; ++rep) attn_phase(A, lds, tid, lane, wave, vcu, G);
#endif
#ifndef NO_TRANSP
#ifndef REP_TR
#define REP_TR 1
#endif
        for (int rep = 0; rep < REP_TR; ++rep) transpose_yt_phase(A, lds, lane, wave, bid, G);
#endif
        __syncthreads(); }
    if (IN(4)) drain_segment(lds, 3);
    SEAM(4);
#ifndef REP_P5
#define REP_P5 1
#endif
    if (IN(5)) { PH_CTX;
        if (G == 256) {
            { pg8::Gemm g{BF(WS_Z), BF(WS_WT_OUT_E), NTOK, 1024, 1024}; pg8::P5Order S; S.pc = (unsigned*)(ws + WS_CTL) + CW_PC5; S.c = bid;
              pg8::EpiResB<0> E{A->in[I_XP], A->in[I_XS], A->out, ws};
              pg8::gemm_phase<pg8::EpiResB<0>, pg8::P5Order, true, true>(RING, g, S, E, wave); }
            panel_queue<true>(lds, 5, 0, 256);
        } else {
            pg8::Gemm g{BF(WS_Z), BF(WS_WT_OUT_E), NTOK, 1024, 1024}; pg8::CountingOrder S; S.init(NTOK, 1024, G, bid); S.pc = (unsigned*)(ws + WS_CTL) + CW_PC5;
            pg8::EpiResB<0> E{A->in[I_XP], A->in[I_XS], A->out, ws};
            pg8::gemm_phase<pg8::EpiResB<0>, pg8::CountingOrder, true, true>(RING, g, S, E, wave);
        }
    }
    if (IN(5)) { PH_CTX;
        if (G == 256 && bid >= 64) {
            pg8::Gemm g{BF(WS_H), BF(WS_WT_IN_O), NPR, 3072, 1024}; pg8::P7GateOrder S; S.pr = (unsigned*)(ws + WS_CTL) + CW_PR; S.tmo = (unsigned*)(ws + WS_CTL) + CW_TMO; S.c = bid;
            pg8::EpiP7 E{ws};
            pg8::gemm_phase<pg8::EpiP7, pg8::P7GateOrder, true, true>(RING, g, S, E, wave);
        }
    }
    if (IN(5)) { PH_CTX; if (G == 256) panel_queue<true>(lds, 7, 256, 64); else panel_queue<true>(lds); }
    SEAM(5);
#ifndef REP_P7
#define REP_P7 1
#endif
    if (IN(7)) for (int rep7 = 0; rep7 < REP_P7; ++rep7) { PH_CTX;
        pg8::Gemm g{BF(WS_H), BF(WS_WT_IN_O), NTOK, 3072, 1024}; pg8::OffsetPlain S;
        if (G == 256) { S.init(NSM, 3072, G, bid); S.pm0 = NPR / 256; } else { S.init(NTOK, 3072, G, bid); S.pm0 = 0; }
        pg8::EpiP7 E{ws};
        pg8::gemm_phase<pg8::EpiP7, pg8::OffsetPlain, true, true>(RING, g, S, E, wave);
    }
    if (IN(7)) drain_segment(lds, 4);
    SEAM(7);
#ifndef REP_DFT
#define REP_DFT 1
#endif
    if (IN(8)) { PH_CTX; for (int rep = 0; rep < REP_DFT; ++rep) { dft_stage1_phase(A, lds, tid, lane, wave, bid, G); dft_prompt_phase(A, lds, tid, lane, wave, bid, G); } __syncthreads(); }
    SEAM(8);
    if (IN(9)) { PH_CTX;
        if (G == 256 && bid < 64) {
            pg8::Gemm g{BF(WS_Z2), BF(WS_WT_OUT_O), NPR, 1024, 1024}; pg8::CountingOrder S; S.init(NPR, 1024, 64, bid); S.pc = (unsigned*)(ws + WS_CTL) + CW_PC10;
            pg8::EpiResB<1> E{nullptr, nullptr, A->out, ws};
            pg8::gemm_phase<pg8::EpiResB<1>, pg8::CountingOrder, true, true>(RING, g, S, E, wave);
        } else if (G == 256) dft_stage2_phase(A, lds, tid, lane, wave, bid - 64, 192);
        else dft_stage2_phase(A, lds, tid, lane, wave, bid, G);
        __syncthreads(); }
    SEAM(9);
    if (IN(10)) { PH_CTX;
        pg8::Gemm g{BF(WS_Z2), BF(WS_WT_OUT_O), NTOK, 1024, 1024}; pg8::OffsetOrder S; S.pc = (unsigned*)(ws + WS_CTL) + CW_PC10;
        if (G == 256) { S.init(NSM, 1024, G, bid); S.pm0 = NPR / 256; } else { S.init(NTOK, 1024, G, bid); S.pm0 = 0; }
        pg8::EpiResB<1> E{nullptr, nullptr, A->out, ws};
        pg8::gemm_phase<pg8::EpiResB<1>, pg8::OffsetOrder, true, true>(RING, g, S, E, wave);
    }
    if (IN(10)) panel_queue<false>(lds);
#ifdef TSK
    STAMP(12);
    { PH_CTX; __syncthreads();
      if (bid == 0) { volatile LAS unsigned* w_ = (volatile LAS unsigned*)((LAS unsigned char*)g_lds + CTXW_OFF);
        const unsigned long long t0 = ((unsigned long long)w_[101 + 2 * (TSK)] << 32) | w_[100 + 2 * (TSK)], t1 = ((unsigned long long)w_[101 + 2 * (TSK2)] << 32) | w_[100 + 2 * (TSK2)];
        const unsigned long long c0 = ((unsigned long long)w_[141 + 2 * (TSK)] << 32) | w_[140 + 2 * (TSK)], c1 = ((unsigned long long)w_[141 + 2 * (TSK2)] << 32) | w_[140 + 2 * (TSK2)];
#ifdef TS_CLOCK
        const float us = (float)(c1 - c0) / (float)(t1 - t0) * 100.0f;
#else
        const float us = (float)(t1 - t0) * 0.01f;
#endif
        const float f = 1.0f + 1e-3f * us; float* sk = A->out + (size_t)NTOK * DM + (size_t)NPR * 256;
        for (int i = tid; i < NPR * 32; i += 512) sk[i] *= f; } }
#endif
#undef IN
#undef SEAM
#undef BF
#undef RING
}

extern "C" void kernel_launch(void* const* d_in, const int* in_sizes, int n_in, void* d_out, int out_size, void* d_ws, size_t ws_size, hipStream_t stream) {
    static int grid = 0;
    if (grid == 0) {
        if (n_in != 27 || out_size != NTOK * DM + NPR * 256 + NPR * 32 || ws_size < WS_END) { fprintf(stderr, "kernel_launch: unexpected shapes (n_in %d out %d ws %zu)\n", n_in, out_size, ws_size); grid = -1; return; }
        int dev = 0, cus = 0, per_cu = 0;
        if (hipGetDevice(&dev) != hipSuccess || hipDeviceGetAttribute(&cus, hipDeviceAttributeMultiprocessorCount, dev) != hipSuccess) { grid = -1; return; }
        if (hipFuncSetAttribute((const void*)fwd_kernel, hipFuncAttributeMaxDynamicSharedMemorySize, LDS_BYTES) != hipSuccess) { fprintf(stderr, "kernel_launch: hipFuncSetAttribute failed\n"); grid = -1; return; }
        if (hipOccupancyMaxActiveBlocksPerMultiprocessor(&per_cu, (const void*)fwd_kernel, NWAVES * 64, LDS_BYTES) != hipSuccess || per_cu < 1) { fprintf(stderr, "kernel_launch: occupancy query says %d blocks per CU\n", per_cu); per_cu = 1; }
        (void)hipGetLastError();
        grid = cus;
    }
    if (grid < 0) return;
    (void)hipMemsetAsync((char*)d_ws + WS_CTL, 0, CTL_ZERO_BYTES, stream);
    Args a{};
    for (int i = 0; i < 27; ++i) a.in[i] = (const float*)d_in[i];
    a.out = (float*)d_out; a.ws = (unsigned char*)d_ws; a.grid = grid; a.pad = 0;
#if MK_N_LAUNCHES == 1
    a.ph_lo = 0; a.ph_hi = NPHASE;
    hipLaunchKernelGGL(fwd_kernel, dim3(grid), dim3(NWAVES * 64), LDS_BYTES, stream, a);
#else
    for (int p = 0; p < NPHASE; ++p) { a.ph_lo = p; a.ph_hi = p + 1; hipLaunchKernelGGL(fwd_kernel, dim3(grid), dim3(NWAVES * 64), LDS_BYTES, stream, a); }
#endif
}
```

```cpp
#include <hip/hip_runtime.h>
#include <cstdio>
#include <cstdint>

#ifndef MK_N_LAUNCHES
#define MK_N_LAUNCHES 1
#endif

constexpr int DM = 1024;
constexpr int NPR = 4096;
constexpr int NSM = 16384;
constexpr int NTOK = NPR + NSM;
constexpr int LPR = 256, LSM = 4096, PAST = 512, LKS = PAST + LSM;
constexpr int NKV = NPR + 4 * LKS;
constexpr int DA = 512, NH = 8, QKD = 96, NOPE = 64, ROPED = 32, VD = 64;
constexpr float EPS = 1e-6f;
constexpr float ATTN_SCALE_LOG2E = 0.10206207261596575f * 1.4426950408889634f;

constexpr size_t MiB = 1u << 20, KiB = 1u << 10;
constexpr size_t WS_CTL = 0, CTL_ZERO_BYTES = 128 * KiB;
constexpr size_t WS_MOD = 1 * MiB;
constexpr size_t WS_ROPE = 1 * MiB + 128 * KiB;
constexpr size_t WS_SSQQ = 1 * MiB + 256 * KiB;
constexpr size_t WS_SSQKV = 1 * MiB + 576 * KiB;
constexpr size_t WS_PQ = 2 * MiB;
constexpr size_t WS_PS = 3 * MiB;
constexpr size_t WS_TW = 5 * MiB;
constexpr size_t WS_WT_IN_E = 6 * MiB;
constexpr size_t WS_WT_UQ = 12 * MiB + 512 * KiB;
constexpr size_t WS_WT_UK = 12 * MiB + 896 * KiB;
constexpr size_t WS_WT_UV = 13 * MiB + 128 * KiB;
constexpr size_t WS_WT_OUT_E = 13 * MiB + 512 * KiB;
constexpr size_t WS_WT_IN_O = 15 * MiB + 512 * KiB;
constexpr size_t WS_WT_OUT_O = 21 * MiB + 512 * KiB;
constexpr size_t WS_KF0 = 24 * MiB;
constexpr size_t WS_KF1 = 32 * MiB;
constexpr size_t WS_H = 36 * MiB;
constexpr size_t WS_VT = 36 * MiB;
constexpr size_t WS_YT = 58 * MiB;
constexpr size_t WS_UT = 78 * MiB;
constexpr size_t WS_Z = 78 * MiB;
constexpr size_t WS_A = 78 * MiB, WS_B = 118 * MiB, WS_SG = 158 * MiB;
constexpr size_t WS_CQ = 158 * MiB;
constexpr size_t WS_CKV = 168 * MiB;
constexpr size_t WS_KR = 179 * MiB;
constexpr size_t WS_SGB = 181 * MiB;
constexpr size_t WS_Q = 201 * MiB;
constexpr size_t WS_KN = 231 * MiB;
constexpr size_t WS_TR = 198 * MiB, WS_TI = 36 * MiB;
constexpr size_t WS_Z2 = 70 * MiB;
constexpr size_t WS_X1B0 = 24 * MiB, WS_X1B1 = 230 * MiB;
constexpr size_t WS_X2B = 110 * MiB;
constexpr size_t WS_END = 254 * MiB;

typedef unsigned short bf16;
typedef float f32x4 __attribute__((ext_vector_type(4)));
typedef float f32x16 __attribute__((ext_vector_type(16)));
typedef unsigned u32x4 __attribute__((ext_vector_type(4)));
typedef unsigned u32x2 __attribute__((ext_vector_type(2)));
typedef short bf16x8 __attribute__((ext_vector_type(8)));

__device__ __forceinline__ unsigned f2bf(float f) { unsigned u = __float_as_uint(f); return (u + 0x7fffu + ((u >> 16) & 1u)) >> 16; }
__device__ __forceinline__ float bf2f(unsigned h) { return __uint_as_float(h << 16); }
__device__ __forceinline__ unsigned pk2(float lo, float hi) { return f2bf(lo) | (f2bf(hi) << 16); }
__device__ __forceinline__ float siluf(float x) { return x * __builtin_amdgcn_rcpf(1.0f + __expf(-x)); }
__device__ __forceinline__ int kvrow_of(int r) { if (r < NPR) return r; const int s = r - NPR; return NPR + (s >> 12) * LKS + PAST + (s & 4095); }
__device__ __forceinline__ bf16* x1b_tile(unsigned char* ws, float* out, int pm) {
    if (pm < 16) return (bf16*)((unsigned char*)out + 16 * MiB) + (size_t)pm * (256 * DM);
    const int s = pm - 16; return (bf16*)(ws + (s < 16 ? WS_X1B0 + (size_t)s * (512 * KiB) : WS_X1B1 + (size_t)(s - 16) * (512 * KiB)));
}
__device__ __forceinline__ void unpack8(const u32x4 w, f32x4& a, f32x4& b) {
    a[0] = __uint_as_float(w.x << 16); a[1] = __uint_as_float(w.x & 0xffff0000u); a[2] = __uint_as_float(w.y << 16); a[3] = __uint_as_float(w.y & 0xffff0000u);
    b[0] = __uint_as_float(w.z << 16); b[1] = __uint_as_float(w.z & 0xffff0000u); b[2] = __uint_as_float(w.w << 16); b[3] = __uint_as_float(w.w & 0xffff0000u);
}

namespace pg8 {
#define PG8_LAS __attribute__((address_space(3)))
typedef unsigned short bf16_t;
typedef short bf16x8 __attribute__((ext_vector_type(8)));
typedef float f32x4 __attribute__((ext_vector_type(4)));
typedef unsigned u32x4 __attribute__((ext_vector_type(4)));
constexpr int BM = 256, BK = 64, HALF = 128, HTB = HALF * BK * 2  , STAGE_BYTES = 8 * HTB, NXCD = 8, WGM = 8;

__host__ __device__ __forceinline__ int lds_byte(int r, int c) { const int st = (r >> 4) * 2 + (c >> 5), rr = r & 15, cc = c & 31, ob = rr * 64 + cc * 2; return st * 1024 + (ob ^ (((ob >> 9) & 1) << 5)); }
__host__ __device__ __forceinline__ void stage_rc(int b, int& R, int& C) { const int st = b / 1024, sb = b % 1024, swz = sb ^ (((sb >> 9) & 1) << 5); R = (st >> 1) * 16 + swz / 64; C = (st & 1) * 32 + (swz % 64) / 2; }
__host__ __device__ __forceinline__ int perm32(int rho) { const int n = rho >> 4, i = rho & 15; return 8 * (i >> 2) + 4 * n + (i & 3); }

struct Unit { int pm, pn, w; };
struct Gemm { const bf16_t* A; const bf16_t* Bt; int M, N, K; const bf16_t* A2 = nullptr; const bf16_t* Bt2 = nullptr; };

struct StaticOrder {
    int nM, nN, nwg, G, c;
    __host__ __device__ void init(int M, int N, int G_, int c_) { nM = M / BM; nN = N / BM; nwg = nM * nN; G = G_; c = c_; }
    __host__ __device__ bool next(int i, Unit& u) const {
        const long L = (long)i * G + c; if (L >= nwg) return false;
        int wgid = (int)L; { const int q = nwg / NXCD, r = nwg % NXCD, xcd = wgid % NXCD, off = wgid / NXCD; wgid = (xcd < r ? xcd * (q + 1) : r * (q + 1) + (xcd - r) * q) + off; }
        const int nig = WGM * nN, gid = wgid / nig, fm = gid * WGM, gsz = (nM - fm) < WGM ? (nM - fm) : WGM;
        u.pm = fm + ((wgid % nig) % gsz); u.pn = (wgid % nig) / gsz; u.w = 0; return true;
    }
    __device__ __forceinline__ void a_ready(const Unit&) const {}
    __device__ __forceinline__ void done(const Unit&) const {}
};

typedef float f32x2_t __attribute__((ext_vector_type(2))); typedef __bf16 bf16x2_t __attribute__((ext_vector_type(2)));
__device__ __forceinline__ unsigned cvt_pk_bf16(float lo, float hi) { f32x2_t v = {lo, hi}; bf16x2_t b = __builtin_convertvector(v, bf16x2_t); return __builtin_bit_cast(unsigned, b); }
__device__ __forceinline__ u32x4 pack8(const f32x4 a, const f32x4 b) { u32x4 w; w.x = cvt_pk_bf16(a[0], a[1]); w.y = cvt_pk_bf16(a[2], a[3]); w.z = cvt_pk_bf16(b[0], b[1]); w.w = cvt_pk_bf16(b[2], b[3]); return w; }
__device__ __forceinline__ f32x4 silu4(f32x4 v) { f32x4 o; o[0] = siluf(v[0]); o[1] = siluf(v[1]); o[2] = siluf(v[2]); o[3] = siluf(v[3]); return o; }
__device__ __forceinline__ f32x4 shfl16_4(f32x4 v) { f32x4 o; o[0] = __shfl_xor(v[0], 16); o[1] = __shfl_xor(v[1], 16); o[2] = __shfl_xor(v[2], 16); o[3] = __shfl_xor(v[3], 16); return o; }
__device__ __forceinline__ void rope4(f32x4& v, int fq, const float* __restrict__ tb) {
    const f32x4 p = shfl16_4(v); const f32x4 t0 = *(const f32x4*)tb, t1 = *(const f32x4*)(tb + 4);
    const float c[4] = {t0[0], t0[2], t1[0], t1[2]}, s[4] = {t0[1], t0[3], t1[1], t1[3]};
    const float sg = (fq & 1) ? 1.0f : -1.0f;
#pragma unroll
    for (int e = 0; e < 4; ++e) v[e] = v[e] * c[e] + sg * (p[e] * s[e]);
}
__device__ __forceinline__ void rope8(f32x4& v0, f32x4& v1, int fq, int t, const float* __restrict__ rope) {
    const int pos = (fq >> 1) ? (t & 63) : (t >> 6);
    rope4(v0, fq, rope + pos * 16); asm volatile("" ::: "memory"); rope4(v1, fq, rope + pos * 16 + 8);
}

struct EpiP2a {
    static constexpr bool PERM = true, AFTER_DRAIN = false;
    unsigned char* ws;
    __device__ __forceinline__ void operator()(const f32x4 (&acc)[2][2][4][2], const Unit& u, int wr, int wc, int fr, int fq) const {
        asm volatile("" : "+v"(fr), "+v"(fq));
        const int row0 = u.pm * BM + wr * 64 + fr, col0 = u.pn * BM + wc * 32 + 8 * fq; const bool act = u.pm >= 6; bf16_t* const UT = (bf16_t*)(ws + WS_UT);
#pragma unroll
        for (int ai = 0; ai < 2; ++ai)
#pragma unroll
            for (int m = 0; m < 4; ++m) { bf16_t* rowp = UT + (size_t)(row0 + ai * HALF + m * 16) * NTOK + col0;
#pragma unroll
                for (int bj = 0; bj < 2; ++bj) { f32x4 v0 = acc[ai][bj][m][0], v1 = acc[ai][bj][m][1]; if (act) { v0 = silu4(v0); v1 = silu4(v1); }
                    { bf16_t* sp_ = rowp + bj * HALF; const u32x4 sv_ = pack8(v0, v1); asm volatile("global_store_dwordx4 %0, %1, off sc1" :: "v"(sp_), "v"(sv_) : "memory"); } } }
    }
};
struct EpiP2b {
    static constexpr bool PERM = true, AFTER_DRAIN = false;
    unsigned char* ws; float* out; const float *qg, *kvg;
    __device__ __forceinline__ void operator()(const f32x4 (&acc)[2][2][4][2], const Unit& u, int wr, int wc, int fr, int fq) const {
        asm volatile("" : "+v"(fr), "+v"(fq));
        const int rowt = u.pm * BM; const bool samp = u.pm >= 16;
        const int kvb = samp ? (NPR + ((u.pm - 16) >> 4) * LKS + PAST + ((u.pm - 16) & 15) * BM) : rowt;
        const int rl0 = wr * 64 + fr, cl0 = wc * 32 + 8 * fq;
        bf16_t* const CQ = (bf16_t*)(ws + WS_CQ); bf16_t* const CKV = (bf16_t*)(ws + WS_CKV); bf16_t* const SGB = (bf16_t*)(ws + WS_SGB); bf16_t* const KR = (bf16_t*)(ws + WS_KR);
        float* const SSQQ = (float*)(ws + WS_SSQQ); float* const SSQKV = (float*)(ws + WS_SSQKV); const float* const rope = (const float*)(ws + WS_ROPE);
        float* const st_ckv = out + (size_t)NTOK * DM; float* const st_krope = st_ckv + (size_t)NPR * 256;
        if (u.pn <= 1) {
            const bool isq = (u.pn == 0);
            const float* gv = isq ? qg : kvg; bf16_t* dst = isq ? CQ : CKV; float* ssq = isq ? SSQQ : SSQKV; const int rb = isq ? rowt : kvb;
            f32x4 g[2][2];
#pragma unroll
            for (int bj = 0; bj < 2; ++bj) { g[bj][0] = *(const f32x4*)(gv + bj * HALF + cl0); g[bj][1] = *(const f32x4*)(gv + bj * HALF + cl0 + 4); }
#pragma unroll
            for (int ai = 0; ai < 2; ++ai)
#pragma unroll
                for (int m = 0; m < 4; ++m) { const int rl = rl0 + ai * HALF + m * 16;
                    float s = 0.f;
#pragma unroll
                    for (int bj = 0; bj < 2; ++bj)
#pragma unroll
                        for (int n = 0; n < 2; ++n) { const f32x4 x = acc[ai][bj][m][n]; s += (x[0] * x[0] + x[1] * x[1]) + (x[2] * x[2] + x[3] * x[3]); }
                    s += __shfl_xor(s, 16); s += __shfl_xor(s, 32);
                    if (fq == 0) ssq[(size_t)(rb + rl) * 4 + wc] = s;
#pragma unroll
                    for (int bj = 0; bj < 2; ++bj) { const f32x4 v0 = acc[ai][bj][m][0] * g[bj][0], v1 = acc[ai][bj][m][1] * g[bj][1];
                        *(u32x4*)(dst + (size_t)(rb + rl) * 256 + bj * HALF + cl0) = pack8(v0, v1);
                        if (!isq && !samp) { float* sp = st_ckv + (size_t)(rowt + rl) * 256 + bj * HALF + cl0; *(f32x4*)sp = v0; *(f32x4*)(sp + 4) = v1; } } }
        } else {
            const int cb = (u.pn - 2) * BM + cl0;
#pragma unroll
            for (int ai = 0; ai < 2; ++ai)
#pragma unroll
                for (int m = 0; m < 4; ++m) { bf16_t* rowp = SGB + (size_t)(rowt + rl0 + ai * HALF + m * 16) * 512 + cb;
#pragma unroll
                    for (int bj = 0; bj < 2; ++bj) *(u32x4*)(rowp + bj * HALF) = pack8(silu4(acc[ai][bj][m][0]), silu4(acc[ai][bj][m][1])); }
        }
    }
};
struct CountingOrder : StaticOrder {
    unsigned* pc;
    __device__ __forceinline__ void done(const Unit& u) const {
        asm volatile("s_waitcnt vmcnt(0)" ::: "memory");
        if (__builtin_amdgcn_mbcnt_hi(~0u, __builtin_amdgcn_mbcnt_lo(~0u, 0u)) == 0u) __hip_atomic_fetch_add(pc + 64 * u.pm, 1u, __ATOMIC_RELAXED, __HIP_MEMORY_SCOPE_AGENT);
    }
};
struct OffsetOrder : CountingOrder {
    int pm0;
    __device__ bool next(int i, Unit& u) const { if (!StaticOrder::next(i, u)) return false; u.pm += pm0; return true; }
};
struct OffsetPlain : StaticOrder {
    int pm0;
    __device__ bool next(int i, Unit& u) const { if (!StaticOrder::next(i, u)) return false; u.pm += pm0; return true; }
};
struct P5Order {
    unsigned* pc; int c;
    __device__ bool next(int i, Unit& u) const { const int x = c & 7, j = c >> 3; u.w = 0;
        if (i == 0) { u.pm = x * 8 + (j & 7); u.pn = j >> 3; return true; }
        if (i == 1 && c < 64) { u.pm = 64 + x * 2 + (j & 1); u.pn = j >> 1; return true; }
        return false; }
    __device__ __forceinline__ void a_ready(const Unit&) const {}
    __device__ __forceinline__ void done(const Unit& u) const {
        asm volatile("s_waitcnt vmcnt(0)" ::: "memory");
        if (__builtin_amdgcn_mbcnt_hi(~0u, __builtin_amdgcn_mbcnt_lo(~0u, 0u)) == 0u) __hip_atomic_fetch_add(pc + 64 * u.pm, 1u, __ATOMIC_RELAXED, __HIP_MEMORY_SCOPE_AGENT);
    }
};
struct P7GateOrder {
    unsigned* pr; unsigned* tmo; int c;
    __device__ bool next(int i, Unit& u) const { if (i) return false; const int x = c & 7, j = (c - 64) >> 3; u.pm = 2 * x + (j & 1); u.pn = j >> 1; u.w = 0; return true; }
    __device__ __forceinline__ void a_ready(const Unit& u) const { unsigned spins = 0;
        while ((unsigned)__builtin_amdgcn_readfirstlane((int)__hip_atomic_load(pr + 64 * u.pm, __ATOMIC_RELAXED, __HIP_MEMORY_SCOPE_AGENT)) < 32u) {
            __builtin_amdgcn_s_sleep(2);
            if (++spins > (1u << 22)) { __hip_atomic_store(tmo, 1u, __ATOMIC_RELAXED, __HIP_MEMORY_SCOPE_AGENT); break; } }
        __builtin_amdgcn_fence(__ATOMIC_ACQUIRE, "agent");
        asm volatile("s_waitcnt vmcnt(0)" ::: "memory"); }
    __device__ __forceinline__ void done(const Unit&) const {}
};
struct TwoOrder {
    StaticOrder s0, s1; int n0, n1, G, c;
    __device__ void init(int M0, int N0, int M1, int N1, int G_, int c_) { s0.init(M0, N0, 1, 0); s1.init(M1, N1, 1, 0); n0 = s0.nwg; n1 = s1.nwg; G = G_; c = c_; }
    __device__ bool next(int i, Unit& u) const { const int L = i * G + c; if (L >= n0 + n1) return false; if (L < n0) { s0.next(L, u); u.w = 0; } else { s1.next(L - n0, u); u.w = 1; } return true; }
    __device__ __forceinline__ void a_ready(const Unit&) const {}
    __device__ __forceinline__ void done(const Unit&) const {}
};
struct EpiP2 {
    static constexpr bool PERM = true, AFTER_DRAIN = false;
    EpiP2a ea; EpiP2b eb;
    __device__ __forceinline__ void operator()(const f32x4 (&acc)[2][2][4][2], const Unit& u, int wr, int wc, int fr, int fq) const { if (u.w == 0) ea(acc, u, wr, wc, fr, fq); else eb(acc, u, wr, wc, fr, fq); }
};
struct EpiP3q {
    static constexpr bool PERM = true, AFTER_DRAIN = false;
    unsigned char* ws;
    __device__ __forceinline__ void operator()(const f32x4 (&acc)[2][2][4][2], const Unit& u, int wr, int wc, int fr, int fq) const {
        asm volatile("" : "+v"(fr), "+v"(fq));
        const int rowt = u.pm * BM; const bool samp = u.pm >= 16; const int rl0 = wr * 64 + fr, cl0 = u.pn * BM + wc * 32 + 8 * fq;
        bf16_t* const Q = (bf16_t*)(ws + WS_Q); const float* const SSQQ = (const float*)(ws + WS_SSQQ); const float* const rope = (const float*)(ws + WS_ROPE); constexpr float scale = ATTN_SCALE_LOG2E;
#pragma unroll
        for (int ai = 0; ai < 2; ++ai)
#pragma unroll
            for (int m = 0; m < 4; ++m) { const int rl = rl0 + ai * HALF + m * 16; const f32x4 s4 = *(const f32x4*)(SSQQ + (size_t)(rowt + rl) * 4);
                const float rs = __builtin_amdgcn_rsqf(((s4[0] + s4[1]) + (s4[2] + s4[3])) * (1.0f / 256.0f) + EPS) * scale;
#pragma unroll
                for (int bj = 0; bj < 2; ++bj) { f32x4 v0 = acc[ai][bj][m][0] * rs, v1 = acc[ai][bj][m][1] * rs;
                    const int g32 = u.pn * 8 + bj * 4 + wc;
                    if (samp && (g32 % 3) == 2) rope8(v0, v1, fq, ((u.pm - 16) & 15) * BM + rl, rope);
                    *(u32x4*)(Q + (size_t)(rowt + rl) * 768 + bj * HALF + cl0) = pack8(v0, v1); }
                asm volatile("" ::: "memory"); }
    }
};
struct EpiP3k {
    static constexpr bool PERM = true, AFTER_DRAIN = false;
    unsigned char* ws;
    __device__ __forceinline__ void operator()(const f32x4 (&acc)[2][2][4][2], const Unit& u, int wr, int wc, int fr, int fq) const {
        asm volatile("" : "+v"(fr), "+v"(fq));
        bf16_t* const KN = (bf16_t*)(ws + WS_KN); const float* const SSQKV = (const float*)(ws + WS_SSQKV);
        const int rowt = u.pm * BM; const bool cache = (u.pm >= 16) && (((u.pm - 16) % 18) < 2); const int rl0 = wr * 64 + fr, cl0 = u.pn * BM + wc * 32 + 8 * fq;
#pragma unroll
        for (int ai = 0; ai < 2; ++ai)
#pragma unroll
            for (int m = 0; m < 4; ++m) { const int rl = rl0 + ai * HALF + m * 16; float rs = 1.0f;
                if (!cache) { const f32x4 s4 = *(const f32x4*)(SSQKV + (size_t)(rowt + rl) * 4); rs = __builtin_amdgcn_rsqf(((s4[0] + s4[1]) + (s4[2] + s4[3])) * (1.0f / 256.0f) + EPS); }
#pragma unroll
                for (int bj = 0; bj < 2; ++bj) *(u32x4*)(KN + (size_t)(rowt + rl) * 512 + bj * HALF + cl0) = pack8(acc[ai][bj][m][0] * rs, acc[ai][bj][m][1] * rs);
                asm volatile("" ::: "memory"); }
    }
};
struct EpiP3v {
    static constexpr bool PERM = true, AFTER_DRAIN = false;
    unsigned char* ws;
    __device__ __forceinline__ void operator()(const f32x4 (&acc)[2][2][4][2], const Unit& u, int wr, int wc, int fr, int fq) const {
        asm volatile("" : "+v"(fr), "+v"(fq));
        bf16_t* const VT = (bf16_t*)(ws + WS_VT); const float* const SSQKV = (const float*)(ws + WS_SSQKV);
        const bool cache = (u.pn >= 16) && (((u.pn - 16) % 18) < 2); const int row0 = u.pm * BM + wr * 64 + fr, col0 = u.pn * BM + wc * 32 + 8 * fq;
#pragma unroll
        for (int bj = 0; bj < 2; ++bj) { f32x4 r0 = {1.f, 1.f, 1.f, 1.f}, r1 = {1.f, 1.f, 1.f, 1.f};
            if (!cache) {
#pragma unroll
                for (int e = 0; e < 4; ++e) { const f32x4 a = *(const f32x4*)(SSQKV + (size_t)(col0 + bj * HALF + e) * 4), b = *(const f32x4*)(SSQKV + (size_t)(col0 + bj * HALF + 4 + e) * 4);
                    r0[e] = __builtin_amdgcn_rsqf(((a[0] + a[1]) + (a[2] + a[3])) * (1.0f / 256.0f) + EPS); r1[e] = __builtin_amdgcn_rsqf(((b[0] + b[1]) + (b[2] + b[3])) * (1.0f / 256.0f) + EPS);
                    asm volatile("" ::: "memory"); } }
#pragma unroll
            for (int ai = 0; ai < 2; ++ai)
#pragma unroll
                for (int m = 0; m < 4; ++m) *(u32x4*)(VT + (size_t)(row0 + ai * HALF + m * 16) * NKV + col0 + bj * HALF) = pack8(acc[ai][bj][m][0] * r0, acc[ai][bj][m][1] * r1); }
    }
};
template <int LAYER>
struct EpiResB {
    static constexpr bool PERM = true, AFTER_DRAIN = false;
    const float* xp; const float* xs; float* out; unsigned char* ws;
    __device__ __forceinline__ void operator()(const f32x4 (&acc)[2][2][4][2], const Unit& u, int wr, int wc, int fr, int fq) const {
        asm volatile("" : "+v"(fr), "+v"(fq));
        const bool samp = u.pm >= 16; const int cond = samp ? 1 + ((u.pm - 16) >> 4) : 0;
        const float* gp = (const float*)(ws + WS_MOD) + LAYER * 5 * 3072 + 2048 + cond * 3072;
        const int rl0 = wr * 64 + fr, cl0 = u.pn * BM + wc * 32 + 8 * fq;
        bf16_t* const x1 = x1b_tile(ws, out, u.pm);
        bf16_t* const dst = LAYER == 0 ? x1 : (bf16_t*)(ws + WS_X2B) + (size_t)u.pm * (BM * DM);
        const float* const xin = samp ? xs + (size_t)(u.pm * BM - NPR) * DM : xp + (size_t)(u.pm * BM) * DM;
#pragma unroll
        for (int bj = 0; bj < 2; ++bj) { const int c = cl0 + bj * HALF; const f32x4 g0 = *(const f32x4*)(gp + c), g1 = *(const f32x4*)(gp + c + 4);
#pragma unroll
            for (int ai = 0; ai < 2; ++ai) { f32x4 xa[4], xb[4];
#pragma unroll
                for (int m = 0; m < 4; ++m) { const int rl = rl0 + ai * HALF + m * 16;
                    if (LAYER == 0) { const float* p = xin + (size_t)rl * DM + c; xa[m] = __builtin_nontemporal_load((const f32x4*)p); xb[m] = __builtin_nontemporal_load((const f32x4*)(p + 4)); }
                    else unpack8(__builtin_nontemporal_load((const u32x4*)(x1 + (size_t)rl * DM + c)), xa[m], xb[m]); }
#pragma unroll
                for (int m = 0; m < 4; ++m) { const int rl = rl0 + ai * HALF + m * 16;
                    const u32x4 ov = pack8(xa[m] + g0 * acc[ai][bj][m][0], xb[m] + g1 * acc[ai][bj][m][1]); bf16_t* op = dst + (size_t)rl * DM + c;
                    asm volatile("global_store_dwordx4 %0, %1, off sc1\n\ts_nop 1" :: "v"(op), "v"(ov) : "memory"); } } }
    }
};
struct EpiP7 {
    static constexpr bool PERM = true, AFTER_DRAIN = false;
    unsigned char* ws;
    __device__ __forceinline__ void operator()(const f32x4 (&acc)[2][2][4][2], const Unit& u, int wr, int wc, int fr, int fq) const {
        asm volatile("" : "+v"(fr), "+v"(fq));
        const int part = u.pn >> 2; bf16_t* dst = (bf16_t*)(ws + WS_A) + (size_t)part * (size_t)(20u << 20); const bool act = part == 2;
        const int row0 = u.pm * BM + wr * 64 + fr, col0 = (u.pn & 3) * BM + wc * 32 + 8 * fq;
#pragma unroll
        for (int ai = 0; ai < 2; ++ai)
#pragma unroll
            for (int m = 0; m < 4; ++m) { bf16_t* rowp = dst + (size_t)(row0 + ai * HALF + m * 16) * DM + col0;
#pragma unroll
                for (int bj = 0; bj < 2; ++bj) { f32x4 v0 = acc[ai][bj][m][0], v1 = acc[ai][bj][m][1]; if (act) { v0 = silu4(v0); v1 = silu4(v1); }
                    { bf16_t* sp_ = rowp + bj * HALF; const u32x4 sv_ = pack8(v0, v1); asm volatile("global_store_dwordx4 %0, %1, off sc1" :: "v"(sp_), "v"(sv_) : "memory"); } } }
    }
};

template <class Epi, class Sched, bool ALIGN_EPI = false, bool SP2 = false>
__device__ __forceinline__ void gemm_phase(PG8_LAS unsigned char* lds, const Gemm g, const Sched& S, const Epi& E, const int wid  ) {
    const int lane = (int)__builtin_amdgcn_mbcnt_hi(~0u, __builtin_amdgcn_mbcnt_lo(~0u, 0u)), tid = wid * 64 + lane, wr = wid >> 2, wc = wid & 3, fr = lane & 15, fq = lane >> 4;
    const int K = g.K, nt = K / BK;
    unsigned voffA[2], voffB[2];
#pragma unroll
    for (int i = 0; i < 2; ++i) { int R, C; stage_rc(tid * 16 + i * 8192, R, C); const int Rb = Epi::PERM ? ((R & ~31) + perm32(R & 31)) : R;
        voffA[i] = (unsigned)(R * K + C) * 2u; voffB[i] = (unsigned)(Rb * K + C) * 2u; }
    const size_t kstep = (size_t)(BK * 2);
    const size_t hstep = (size_t)HALF * K * 2;
    const size_t tstep = 2 * hstep;
    const unsigned ldsw = (unsigned)wid * 1024u;
    const int aoff = lds_byte(wr * 64 + fr, fq * 8), boff = lds_byte(wc * 32 + fr, fq * 8);
#define PG8_SA(b, h) (((b) * 2 + (h)) * HTB)
#define PG8_SB(b, h) ((4 + (b) * 2 + (h)) * HTB)
#define PG8_STAGE(bufoff, gbase, voff) do { _Pragma("unroll") for (int _i = 0; _i < 2; ++_i) \
        __builtin_amdgcn_global_load_lds((const unsigned*)((const char*)(gbase) + (voff)[_i]), (PG8_LAS unsigned*)(lds + (bufoff) + ldsw + _i * 8192), 16, 0, 0); } while (0)
#define PG8_LDA(dst, b, h) do { _Pragma("unroll") for (int m = 0; m < 4; ++m) _Pragma("unroll") for (int k = 0; k < 2; ++k) dst[m][k] = *(const PG8_LAS bf16x8*)(lds + PG8_SA(b, h) + aoff + m * 2048 + k * 1024); } while (0)
#define PG8_LDB(dst, b, h) do { _Pragma("unroll") for (int n = 0; n < 2; ++n) _Pragma("unroll") for (int k = 0; k < 2; ++k) dst[n][k] = *(const PG8_LAS bf16x8*)(lds + PG8_SB(b, h) + boff + n * 2048 + k * 1024); } while (0)
#define PG8_MMA(ai, bj, At, Bt) do { __builtin_amdgcn_s_setprio(1); _Pragma("unroll") for (int m = 0; m < 4; ++m) _Pragma("unroll") for (int n = 0; n < 2; ++n) _Pragma("unroll") for (int k = 0; k < 2; ++k) \
        acc[ai][bj][m][n] = __builtin_amdgcn_mfma_f32_16x16x32_bf16(Bt[n][k], At[m][k], acc[ai][bj][m][n], 0, 0, 0); __builtin_amdgcn_s_setprio(0); } while (0)
#define PG8_WAIT_V(n) asm volatile("s_waitcnt vmcnt(" #n ")" ::: "memory")
#define PG8_WAIT_L(n) asm volatile("s_waitcnt lgkmcnt(" #n ")" ::: "memory")
#define PG8_BAR __builtin_amdgcn_s_barrier()
#define PG8_SCHED __builtin_amdgcn_sched_barrier(0)
    Unit cur, nxt; int ui = 0;
    if (!S.next(0, cur)) return;
    f32x4 acc[2][2][4][2];
#pragma unroll
    for (int a = 0; a < 2; ++a)
#pragma unroll
        for (int b = 0; b < 2; ++b)
#pragma unroll
            for (int m = 0; m < 4; ++m)
#pragma unroll
                for (int n = 0; n < 2; ++n) acc[a][b][m][n] = (f32x4){0.f, 0.f, 0.f, 0.f};
    bf16x8 At[4][2], B0[2][2], B1[2][2];
    const char* cA = (const char*)(cur.w ? g.A2 : g.A) + (size_t)cur.pm * tstep; const char* cB = (const char*)(cur.w ? g.Bt2 : g.Bt) + (size_t)cur.pn * tstep;
    S.a_ready(cur);
    if constexpr (SP2) {
        PG8_STAGE(PG8_SB(0, 0), cB, voffB); PG8_STAGE(PG8_SB(0, 1), cB + hstep, voffB); PG8_STAGE(PG8_SA(0, 0), cA, voffA); PG8_STAGE(PG8_SA(0, 1), cA + hstep, voffA);
        if (wr == 1) PG8_BAR;
        PG8_WAIT_V(2); PG8_BAR;
        PG8_STAGE(PG8_SB(1, 0), cB + kstep, voffB); PG8_STAGE(PG8_SA(1, 0), cA + kstep, voffA); PG8_STAGE(PG8_SB(1, 1), cB + hstep + kstep, voffB);
        PG8_WAIT_V(6); PG8_BAR;
    } else {
        PG8_STAGE(PG8_SB(0, 0), cB, voffB); PG8_STAGE(PG8_SA(0, 0), cA, voffA); PG8_STAGE(PG8_SB(0, 1), cB + hstep, voffB); PG8_STAGE(PG8_SA(0, 1), cA + hstep, voffA);
        if (wr == 1) PG8_BAR;
        PG8_WAIT_V(4); PG8_BAR;
        PG8_STAGE(PG8_SB(1, 0), cB + kstep, voffB); PG8_STAGE(PG8_SA(1, 0), cA + kstep, voffA); PG8_STAGE(PG8_SB(1, 1), cB + hstep + kstep, voffB);
        PG8_WAIT_V(6); PG8_BAR;
    }
    for (;;) {
        const bool has_next = S.next(ui + 1, nxt);
        const char* nA = has_next ? (const char*)(nxt.w ? g.A2 : g.A) + (size_t)nxt.pm * tstep : cA; const char* nB = has_next ? (const char*)(nxt.w ? g.Bt2 : g.Bt) + (size_t)nxt.pn * tstep : cB;
        for (int t = 0; t < nt; t += 2) {
            const bool last = (t == nt - 2);
            const char* a1 = cA + (size_t)(t + 1) * kstep;
            const char* a2 = last ? nA : cA + (size_t)(t + 2) * kstep; const char* b2 = last ? nB : cB + (size_t)(t + 2) * kstep;
            const char* a3 = a2 + kstep; const char* b3 = b2 + kstep;
            if (last && has_next) S.a_ready(nxt);
            if constexpr (SP2) {
            PG8_LDB(B0, 0, 0); PG8_LDB(B1, 0, 1); PG8_SCHED; PG8_LDA(At, 0, 0); PG8_STAGE(PG8_SA(1, 1), a1 + hstep, voffA);
            PG8_WAIT_V(8); PG8_WAIT_L(0); PG8_BAR; PG8_MMA(0, 0, At, B0); PG8_MMA(0, 1, At, B1); PG8_BAR; PG8_SCHED;
            PG8_LDA(At, 0, 1); PG8_STAGE(PG8_SB(0, 0), b2, voffB); PG8_STAGE(PG8_SB(0, 1), b2 + hstep, voffB); PG8_STAGE(PG8_SA(0, 0), a2, voffA);
            PG8_WAIT_V(8); PG8_WAIT_L(0); PG8_BAR; PG8_MMA(1, 0, At, B0); PG8_MMA(1, 1, At, B1); PG8_BAR; PG8_SCHED;
            PG8_LDB(B0, 1, 0); PG8_LDB(B1, 1, 1); PG8_SCHED; PG8_LDA(At, 1, 0); PG8_STAGE(PG8_SA(0, 1), a2 + hstep, voffA);
            PG8_WAIT_V(8); PG8_WAIT_L(0); PG8_BAR; PG8_MMA(0, 0, At, B0); PG8_MMA(0, 1, At, B1); PG8_BAR; PG8_SCHED;
            PG8_LDA(At, 1, 1); PG8_STAGE(PG8_SB(1, 0), b3, voffB); PG8_STAGE(PG8_SB(1, 1), b3 + hstep, voffB); PG8_STAGE(PG8_SA(1, 0), a3, voffA);
            PG8_WAIT_V(8); PG8_WAIT_L(0); PG8_BAR; PG8_MMA(1, 0, At, B0); PG8_MMA(1, 1, At, B1); PG8_BAR; PG8_SCHED;
            } else {
            PG8_LDB(B0, 0, 0); PG8_SCHED; PG8_LDA(At, 0, 0); PG8_STAGE(PG8_SA(1, 1), a1 + hstep, voffA);
            PG8_WAIT_L(8); PG8_BAR; PG8_WAIT_L(0); PG8_MMA(0, 0, At, B0); PG8_BAR; PG8_SCHED;
            PG8_LDB(B1, 0, 1); PG8_STAGE(PG8_SB(0, 0), b2, voffB);
            PG8_BAR; PG8_WAIT_L(0); PG8_MMA(0, 1, At, B1); PG8_BAR;
            PG8_LDA(At, 0, 1); PG8_STAGE(PG8_SA(0, 0), a2, voffA);
            PG8_BAR; PG8_WAIT_L(0); PG8_MMA(1, 0, At, B0); PG8_BAR; PG8_SCHED;
            PG8_STAGE(PG8_SB(0, 1), b2 + hstep, voffB);
            PG8_WAIT_V(6); PG8_BAR; PG8_MMA(1, 1, At, B1); PG8_BAR;
            PG8_LDB(B0, 1, 0); PG8_SCHED; PG8_LDA(At, 1, 0); PG8_STAGE(PG8_SA(0, 1), a2 + hstep, voffA);
            PG8_WAIT_L(8); PG8_BAR; PG8_WAIT_L(0); PG8_MMA(0, 0, At, B0); PG8_BAR; PG8_SCHED;
            PG8_LDB(B1, 1, 1); PG8_STAGE(PG8_SB(1, 0), b3, voffB);
            PG8_BAR; PG8_WAIT_L(0); PG8_MMA(0, 1, At, B1); PG8_BAR;
            PG8_LDA(At, 1, 1); PG8_STAGE(PG8_SA(1, 0), a3, voffA);
            PG8_BAR; PG8_WAIT_L(0); PG8_MMA(1, 0, At, B0); PG8_BAR; PG8_SCHED;
            PG8_STAGE(PG8_SB(1, 1), b3 + hstep, voffB);
            PG8_WAIT_V(6); PG8_BAR; PG8_MMA(1, 1, At, B1); PG8_BAR;
            }
        }
        if constexpr (ALIGN_EPI) { if (wr == 0) PG8_BAR; }
        if constexpr (!Epi::AFTER_DRAIN) { E(acc, cur, wr, wc, fr, fq); S.done(cur); }
        if (!has_next) break;
#pragma unroll
        for (int a = 0; a < 2; ++a)
#pragma unroll
            for (int b = 0; b < 2; ++b)
#pragma unroll
                for (int m = 0; m < 4; ++m)
#pragma unroll
                    for (int n = 0; n < 2; ++n) acc[a][b][m][n] = (f32x4){0.f, 0.f, 0.f, 0.f};
        cur = nxt; cA = nA; cB = nB; ++ui;
        if constexpr (ALIGN_EPI) { if (wr == 1) PG8_BAR; }
    }
    PG8_WAIT_V(0);
    if constexpr (!ALIGN_EPI) { if (wr == 0) PG8_BAR; }
    PG8_BAR;
    if constexpr (Epi::AFTER_DRAIN) { E.fused(acc, cur, wr, wc, fr, fq, lds, wid, lane); S.done(cur); }
#undef PG8_SA
#undef PG8_SB
#undef PG8_STAGE
#undef PG8_LDA
#undef PG8_LDB
#undef PG8_MMA
#undef PG8_WAIT_V
#undef PG8_WAIT_L
#undef PG8_BAR
#undef PG8_SCHED
}
}
#define GAS __attribute__((address_space(1)))
#define LAS __attribute__((address_space(3)))
typedef unsigned short bf16;
typedef unsigned v4u __attribute__((ext_vector_type(4)));
typedef float f32x4 __attribute__((ext_vector_type(4)));
typedef short bf16x8 __attribute__((ext_vector_type(8)));
typedef GAS unsigned gu32;
typedef GAS unsigned long long gu64;
#define RLX_AGENT __ATOMIC_RELAXED, __HIP_MEMORY_SCOPE_AGENT
#define LDS_WAIT() asm volatile("s_waitcnt lgkmcnt(0)" ::: "memory")
#define VM_WAIT() asm volatile("s_waitcnt vmcnt(0)" ::: "memory")
__device__ __forceinline__ unsigned long long rt() { return __builtin_amdgcn_s_memrealtime(); }

#define XB_TMO      128
#define XB_XCNT(j)  (256  + 64 * (j))
#define XB_XSUB(j)  (1280 + 64 * (j))
#define XB_XGEN(j)  (2304 + 64 * (j))
#define XB_TOP      3328
#define XB_TOPGEN   3392
#define XCD_BAR_WORDS 3456
#define XB_SPIN_CAP (1u << 18)

__device__ __forceinline__ unsigned xb_ld(unsigned* p)              { return __hip_atomic_load(p, __ATOMIC_RELAXED, __HIP_MEMORY_SCOPE_AGENT); }
__device__ __forceinline__ unsigned xb_add(unsigned* p, unsigned v) { return __hip_atomic_fetch_add(p, v, __ATOMIC_RELAXED, __HIP_MEMORY_SCOPE_AGENT); }
__device__ __forceinline__ unsigned xb_xcc_id() { return (unsigned)__builtin_amdgcn_s_getreg((3 << 11) | 20) & 0xFu; }
#define XB_SPIN(cond, bar) do { unsigned _sp = 0; while (cond) { __builtin_amdgcn_s_sleep(1); \
    if ((++_sp & 255u) == 0u) { if (xb_ld(&(bar)[XB_TMO])) break; if (_sp > XB_SPIN_CAP) { atomicAdd(&(bar)[XB_TMO], 1u); break; } } } } while (0)

struct XcdBarrier {
    unsigned* bar; unsigned x;
    volatile LAS unsigned* st;
};

__device__ __forceinline__ XcdBarrier xcd_barrier_post(unsigned* bar, volatile LAS unsigned* st, const bool t0) {
    XcdBarrier b; b.bar = bar; b.x = xb_xcc_id(); b.st = st;
    if (t0) (void)xb_add(&bar[XB_XCNT(b.x)], 1u);
    return b;
}
__device__ __forceinline__ void xcd_barrier_complete(unsigned* bar, unsigned x, unsigned& nloc, unsigned& nx) {
    const unsigned G = gridDim.x * gridDim.y * gridDim.z;
    unsigned sum, cnt, mine, sp = 0u;
    for (;;) {
        sum = 0u; cnt = 0u; mine = 0u;
#pragma unroll
        for (unsigned j = 0; j < 16; ++j) { const unsigned c = xb_ld(&bar[XB_XCNT(j)]); sum += c; cnt += (c > 0u) ? 1u : 0u; mine = (j == x) ? c : mine; }
        if (sum == G) break;
        __builtin_amdgcn_s_sleep(1);
        if ((++sp & 255u) == 0u) { if (xb_ld(&bar[XB_TMO])) break; if (sp > XB_SPIN_CAP) { atomicAdd(&bar[XB_TMO], 1u); break; } }
    }
    nloc = mine > 0u ? mine : 1u; nx = cnt > 0u ? cnt : 1u;
}

__device__ __forceinline__ void xcd_barrier(const XcdBarrier& b, const bool t0) {
    asm volatile("s_waitcnt vmcnt(0)" ::: "memory");
    __syncthreads();
    if (t0) {
        unsigned* bar = b.bar;
        __builtin_amdgcn_s_waitcnt(0);
        unsigned nloc = b.st[0], nx = b.st[1];
        if (nloc == 0u) { xcd_barrier_complete(bar, b.x, nloc, nx); b.st[0] = nloc; b.st[1] = nx; }
        const unsigned old = xb_add(&bar[XB_XSUB(b.x)], 1u);
        const unsigned gen = old / nloc;
        if (old + 1u == (gen + 1u) * nloc) {
            __builtin_amdgcn_fence(__ATOMIC_RELEASE, "agent");
            asm volatile("s_waitcnt vmcnt(0)" ::: "memory");
            const unsigned og = xb_add(&bar[XB_TOP], 1u);
            const unsigned tg = og / nx;
            if (og + 1u == (tg + 1u) * nx) xb_add(&bar[XB_TOPGEN], 1u);
            else XB_SPIN(xb_ld(&bar[XB_TOPGEN]) == tg, bar);
            __builtin_amdgcn_fence(__ATOMIC_ACQUIRE, "agent");
            xb_add(&bar[XB_XGEN(b.x)], 1u);
            asm volatile("s_waitcnt vmcnt(0)" ::: "memory");
        } else {
            XB_SPIN(xb_ld(&bar[XB_XGEN(b.x)]) == gen, bar);
            __builtin_amdgcn_fence(__ATOMIC_ACQUIRE, "agent");
            asm volatile("s_waitcnt vmcnt(0)" ::: "memory");
        }
    }
    __syncthreads();
}


constexpr int NWAVES = 8;
constexpr int RING_BYTES = 131072;
constexpr int LDSCTL_OFF = RING_BYTES, MISC_OFF = LDSCTL_OFF + 320;
constexpr int LDS_BYTES = 147456;
constexpr int CW_TMO = 0, CW_CODE = 1, CW_BAR = 4096;
static_assert((CW_BAR + 3456) * 4 <= (int)CTL_ZERO_BYTES, "ctl");

struct Args { const float* in[27]; float* out; unsigned char* ws; int ph_lo, ph_hi, grid, pad; };
typedef const Args __attribute__((address_space(4)))* ArgsP;
extern __shared__ __attribute__((aligned(16))) unsigned char g_lds[];
constexpr int CTXW_OFF = LDSCTL_OFF;
struct Ctx { ArgsP a; int wave, bid; };
__device__ __forceinline__ unsigned hw_slot() { return (unsigned)__builtin_amdgcn_s_getreg((5 << 11) | 4) & 63u; }
__device__ __forceinline__ Ctx get_ctx() {
    volatile LAS unsigned* cw = (volatile LAS unsigned*)((LAS unsigned char*)g_lds + CTXW_OFF);
    Ctx c; c.wave = __builtin_amdgcn_readfirstlane((int)cw[hw_slot()]); c.bid = __builtin_amdgcn_readfirstlane((int)cw[64]);
    const unsigned lo = (unsigned)__builtin_amdgcn_readfirstlane((int)cw[66]), hi = (unsigned)__builtin_amdgcn_readfirstlane((int)cw[67]);
    c.a = (ArgsP)(uintptr_t)(((unsigned long long)hi << 32) | lo); return c;
}
#define LANE_ID() ((int)__builtin_amdgcn_mbcnt_hi(~0u, __builtin_amdgcn_mbcnt_lo(~0u, 0u)))
enum { I_XP = 0, I_XS, I_C, I_CCKV, I_CKR, I_CCTX, I_NORMG, I_WMOD, I_BMOD, I_WINE, I_CONVW, I_CONVB, I_FW1, I_FB1, I_FW2, I_FB2, I_FW3, I_SKIP, I_QG, I_KVG, I_WUQ, I_WUKV, I_WOUTE, I_WINO, I_FNETW, I_WOUTO, I_FINALG };

__device__ __forceinline__ float wave_sum(float v) {
#pragma unroll
    for (int o = 1; o < 64; o <<= 1) v += __shfl_xor(v, o);
    return v;
}

__device__ __forceinline__ void transpose_item(const float* __restrict__ src, int pitch, int k0, int n0, bf16* __restrict__ dst, int K, float* scr, int lane) {
#pragma unroll 8
    for (int i = 0; i < 32; ++i) { const int kk = 2 * i + (lane >> 5); scr[kk * 33 + (lane & 31)] = src[(size_t)(k0 + kk) * pitch + n0 + (lane & 31)]; }
    __builtin_amdgcn_s_waitcnt(0xc07f); asm volatile("" ::: "memory");
    const int c = lane & 7;
#pragma unroll
    for (int j = 0; j < 4; ++j) { const int n = (lane >> 3) + 8 * j; const float* s = scr + (8 * c) * 33 + n;
        u32x4 o; o.x = pk2(s[0 * 33], s[1 * 33]); o.y = pk2(s[2 * 33], s[3 * 33]); o.z = pk2(s[4 * 33], s[5 * 33]); o.w = pk2(s[6 * 33], s[7 * 33]);
        *(u32x4*)(dst + (size_t)n * K + k0 + 8 * c) = o; }
    __builtin_amdgcn_s_waitcnt(0xc07f); asm volatile("" ::: "memory");
}

#define P0_CTX const Ctx cx_ = get_ctx(); ArgsP a = cx_.a; const int G = a->grid, bid = cx_.bid; const int wave = cx_.wave, lane = LANE_ID(), tid = wave * 64 + lane; \
    unsigned char* const ws = a->ws; float* const lf = (float*)lds; (void)G; (void)bid; (void)lane; (void)wave; (void)ws; (void)lf
constexpr int CW_Q0 = 64;
constexpr int CW_ADA = 128;
constexpr int CW_PC5 = 8192, CW_PC10 = 16384, CW_PR = 24576;
constexpr int SEG_N[5] = {192 + 64 + 3 + 320 + 194, 16 + 72 + 80 + 72 + 28, 64, 256 + 64, 64};
__device__ __forceinline__ void p0_ada_task(unsigned char* lds, int task) { P0_CTX;
    float* sc = lf; float* red = lf + 5 * 1024; float* MOD = (float*)(ws + WS_MOD);
    const int l = task / 96, n0 = (task % 96) * 32;
    for (int i = tid; i < 5 * 1024; i += 512) { const int cnd = i >> 10, k = i & 1023; const float x = cnd == 0 ? a->in[I_CCTX][k] : a->in[I_C][(cnd - 1) * 1024 + k]; sc[i] = x / (1.0f + expf(-x)); }
    __syncthreads();
    const int col = tid & 31, ks = tid >> 5; float acc[5] = {0.f, 0.f, 0.f, 0.f, 0.f};
    const float* w = a->in[I_WMOD] + (size_t)l * 1024 * 3072 + n0 + col;
#pragma unroll 16
    for (int k = ks * 64; k < ks * 64 + 64; ++k) { const float wv = w[(size_t)k * 3072];
#pragma unroll
        for (int cnd = 0; cnd < 5; ++cnd) acc[cnd] += sc[cnd * 1024 + k] * wv; }
#pragma unroll
    for (int cnd = 0; cnd < 5; ++cnd) red[(ks * 5 + cnd) * 32 + col] = acc[cnd];
    __syncthreads();
    if (tid < 160) { const int cnd = tid >> 5, cc = tid & 31; float s = a->in[I_BMOD][l * 3072 + n0 + cc];
        for (int k2 = 0; k2 < 16; ++k2) s += red[(k2 * 5 + cnd) * 32 + cc];
        __hip_atomic_store(MOD + (l * 5 + cnd) * 3072 + n0 + cc, s, __ATOMIC_RELAXED, __HIP_MEMORY_SCOPE_AGENT); }
    asm volatile("s_waitcnt vmcnt(0)" ::: "memory");
    __syncthreads();
    if (tid == 0) __hip_atomic_fetch_add((unsigned*)(ws + WS_CTL) + CW_ADA, 1u, __ATOMIC_RELAXED, __HIP_MEMORY_SCOPE_AGENT);
}
__device__ __forceinline__ void p0_filter_task(unsigned char* lds, int task) { P0_CTX;
    float* z = lf; float* h1 = lf + 1056; float* h2 = h1 + 2048;
    float* PS = (float*)(ws + WS_PS);
    const float *w1 = a->in[I_FW1], *b1 = a->in[I_FB1], *w2 = a->in[I_FW2], *b2 = a->in[I_FB2], *w3 = a->in[I_FW3];
    const int sel = task < 128 ? 0 : 1, chunk = sel ? task - 128 : task, L = sel ? 256 : 4096, p0 = chunk * 32;
    bf16* KF = (bf16*)(ws + (sel ? WS_KF1 : WS_KF0));
    for (int o = tid; o < 32 * 33; o += 512) { const int p = o / 33, i = o % 33, pos = p0 + p; float v;
        if (i == 0) v = (float)pos / (float)(L - 1);
        else { const int bi = (i - 1) & 15; const float f = 1e-4f + (float)bi * ((15.0f - 1e-4f) / 15.0f), rev = f * ((float)pos / (float)L);
            v = (i <= 16) ? __builtin_amdgcn_cosf(rev) : -__builtin_amdgcn_sinf(rev); }
        z[p * 33 + i] = v; }
    __syncthreads();
    for (int o = tid; o < 2048; o += 512) { const int p = o >> 6, j = o & 63; float s = b1[j];
#pragma unroll 11
        for (int i = 0; i < 33; ++i) s += z[p * 33 + i] * w1[i * 64 + j];
        h1[o] = __sinf(s); }
    __syncthreads();
    for (int o = tid; o < 2048; o += 512) { const int p = o >> 6, j = o & 63; float s = b2[j];
#pragma unroll 16
        for (int i = 0; i < 64; ++i) s += h1[p * 64 + i] * w2[i * 64 + j];
        h2[p * 65 + j] = __sinf(s); }
    __syncthreads();
    const int r32 = lane & 31, hi = lane >> 5;
    bf16x8 Ah[4], Al[4];
#pragma unroll
    for (int sI = 0; sI < 4; ++sI)
#pragma unroll
        for (int e = 0; e < 8; ++e) { const float x = h2[r32 * 65 + 16 * sI + 8 * hi + e]; const unsigned h = f2bf(x); Ah[sI][e] = (short)h; Al[sI][e] = (short)f2bf(x - bf2f(h)); }
    const float* w3l = w3 + (size_t)(8 * hi) * 1024 + (4 * wave) * 32 + r32;
#pragma unroll 1
    for (int nbi = 0; nbi < 4; ++nbi) { const int n = (4 * wave + nbi) * 32 + r32, dir = n >> 9, c = n & 511;
        float braw[32];
#pragma unroll
        for (int q = 0; q < 32; ++q) braw[q] = w3l[(size_t)(16 * (q >> 3) + (q & 7)) * 1024 + nbi * 32];
        f32x16 acc = {};
#pragma unroll
        for (int sI = 0; sI < 4; ++sI) { bf16x8 Bh, Bl;
#pragma unroll
            for (int e = 0; e < 8; ++e) { const float x = braw[8 * sI + e]; const unsigned h = f2bf(x); Bh[e] = (short)h; Bl[e] = (short)f2bf(x - bf2f(h)); }
            acc = __builtin_amdgcn_mfma_f32_32x32x16_bf16(Ah[sI], Bh, acc, 0, 0, 0); acc = __builtin_amdgcn_mfma_f32_32x32x16_bf16(Al[sI], Bh, acc, 0, 0, 0); acc = __builtin_amdgcn_mfma_f32_32x32x16_bf16(Ah[sI], Bl, acc, 0, 0, 0); }
        const float delta = 3.0701134573253946f + (float)c * ((15.350567286626973f - 3.0701134573253946f) / 511.0f); float ps = 0.f;
        unsigned char* tile = lds + 32768 + wave * 2560;
#pragma unroll
        for (int g = 0; g < 4; ++g) { const int q0 = p0 + 8 * g + 4 * hi; unsigned hv[4];
#pragma unroll
            for (int e = 0; e < 4; ++e) { const float t = (float)(q0 + e) / (float)(L - 1); const float v = acc[4 * g + e] * __expf(-t * delta); ps += fabsf(v); hv[e] = f2bf(v); }
            *(u32x2*)(tile + r32 * 80 + (8 * g + 4 * hi) * 2) = (u32x2){hv[0] | (hv[1] << 16), hv[2] | (hv[3] << 16)}; }
        ps += __shfl_xor(ps, 32);
        if (hi == 0) PS[(size_t)(sel * 256 + chunk) * 1024 + n] = ps;
#pragma unroll
        for (int j = 0; j < 2; ++j) { const int ch = (lane >> 2) + 16 * j, piece = lane & 3; const u32x4 w = *(const u32x4*)(tile + ch * 80 + piece * 16);
            bf16* row = KF + (size_t)(((4 * wave + nbi) * 32 + ch) & 511) * (2 * L);
            if (dir == 0) *(u32x4*)(row + L + p0 + 8 * piece) = w;
            else {
                bf16* bp = row + (L - p0 - 8 * piece - 7);
                bp[0] = (bf16)(w.w >> 16);
                *(unsigned*)(bp + 1) = (w.w & 0xffffu) | (w.z & 0xffff0000u);
                *(u32x2*)(bp + 3) = (u32x2){(w.z & 0xffffu) | (w.y & 0xffff0000u), (w.y & 0xffffu) | (w.x & 0xffff0000u)};
                if (p0 + 8 * piece == 0) row[0] = (bf16)0u; else bp[7] = (bf16)(w.x & 0xffffu); }
        }
    }
}
__device__ __forceinline__ void p0_pq_task(unsigned char* lds, int task) { P0_CTX;
    float* tab = lf;
    if (tid < 128) { tab[2 * tid] = (float)cos(6.283185307179586476925 * (double)tid / 128.0); tab[2 * tid + 1] = (float)sin(6.283185307179586476925 * (double)tid / 128.0); }
    __syncthreads();
    float* PQ = (float*)(ws + WS_PQ); const int half = task >> 3, g = task & 7; const float* Wf = a->in[I_FNETW] + (size_t)g * 16384;
    const int r32 = lane & 31, hi = lane >> 5, c = 32 * (wave >> 1) + r32;
#pragma unroll 1
    for (int nbi = 0; nbi < 2; ++nbi) { const int d = 32 * (2 * (wave & 1) + nbi) + r32;
        f32x16 acc = {};
#pragma unroll 16
        for (int kk = 0; kk < 64; ++kk) { const int j = 2 * kk + hi; acc = __builtin_amdgcn_mfma_f32_32x32x2f32(tab[2 * ((c * j) & 127) + half], Wf[(size_t)j * 128 + d], acc, 0, 0, 0); }
#pragma unroll
        for (int r = 0; r < 16; ++r) { const int cr = 32 * (wave >> 1) + (r & 3) + 8 * (r >> 2) + 4 * hi; PQ[(size_t)((half * 8 + g) * 128 + cr) * 128 + d] = acc[r] * 0.08838834764831845f; } }
}
__device__ __forceinline__ void p0_wt_task(unsigned char* lds, int task, int item0, int item1) { P0_CTX;
    float* scr = lf + wave * (64 * 33);
    const int it = item0 + task * NWAVES + wave;
    if (it < item1) {
        int r = it, si, pitch, K, kb, nb, n0; size_t doff;
        if (r < 1552) { si = I_WINE; pitch = 3104; K = 1024; kb = r / 97; nb = r % 97; n0 = 32 * nb; const int drow = nb < 80 ? 32 * nb : (nb == 80 ? 3072 : 32 * nb - 32); doff = WS_WT_IN_E + (size_t)drow * 2048; }
        else if ((r -= 1552) < 96) { si = I_WUQ; pitch = 768; K = 256; kb = r / 24; nb = r % 24; n0 = 32 * nb; doff = WS_WT_UQ + (size_t)(32 * nb) * 512; }
        else if ((r -= 96) < 128) { si = I_WUKV; pitch = 1024; K = 256; kb = r / 32; nb = r % 32; n0 = 32 * nb; const int h = nb >> 2, part = nb & 3;
            doff = (part < 2) ? WS_WT_UK + (size_t)(h * 64 + 32 * part) * 512 : WS_WT_UV + (size_t)(h * 64 + 32 * (part - 2)) * 512; }
        else if ((r -= 128) < 512) { si = I_WOUTE; pitch = 1024; K = 1024; kb = r / 32; nb = r % 32; n0 = 32 * nb; doff = WS_WT_OUT_E + (size_t)(32 * nb) * 2048; }
        else if ((r -= 512) < 512) { si = I_WINO; pitch = 2048; K = 1024; kb = r / 32; nb = r % 32; n0 = 1024 + 32 * nb; doff = WS_WT_IN_O + (size_t)(2048 + 32 * nb) * 2048; }
        else { r -= 512; si = I_WOUTO; pitch = 1024; K = 1024; kb = r / 32; nb = r % 32; n0 = 32 * nb; doff = WS_WT_OUT_O + (size_t)(32 * nb) * 2048; }
        transpose_item(a->in[si], pitch, 64 * kb, n0, (bf16*)(ws + doff), K, scr, lane);
    }
}
__device__ __forceinline__ void p0_misc_task(unsigned char* lds, int task) { P0_CTX;
#pragma unroll 1
    for (int it = 0; it < 4; ++it) {
        if (task < 14) { const int i = task * 2048 + it * 512 + tid; ((u32x4*)((bf16*)(ws + WS_WT_IN_E) + (size_t)3104 * 1024))[i] = (u32x4){0u, 0u, 0u, 0u}; }
        else if (task < 78) { const int i = (task - 14) * 2048 + it * 512 + tid; bf16* CKV = (bf16*)(ws + WS_CKV); const float* src = a->in[I_CCKV];
            const int e = i * 4, b = e >> 17, p = (e >> 8) & 511, c = e & 255; const f32x4 v = *(const f32x4*)(src + e);
            u32x2 o; o.x = pk2(v[0], v[1]); o.y = pk2(v[2], v[3]); *(u32x2*)(CKV + (size_t)(NPR + b * LKS + p) * 256 + c) = o; }
        else if (task < 86) { const int i = (task - 78) * 2048 + it * 512 + tid; bf16* KR = (bf16*)(ws + WS_KR); const float* src = a->in[I_CKR];
            const int e = i * 4, b = e >> 14, p = (e >> 5) & 511, c = e & 31; const f32x4 v = *(const f32x4*)(src + e);
            u32x2 o; o.x = pk2(v[0], v[1]); o.y = pk2(v[2], v[3]); *(u32x2*)(KR + (size_t)(NPR + b * LKS + p) * 32 + c) = o; }
        else { const int i = (task - 86) * 2048 + it * 512 + tid;
            if (i < 512) { float* rope = (float*)(ws + WS_ROPE); const int pos = i >> 3, f = i & 7; const double ang = (double)pos * pow(10000.0, -(double)f / 8.0); rope[2 * i] = (float)cos(ang); rope[2 * i + 1] = (float)sin(ang); }
            else if (i < 512 + 4416) { float* tw = (float*)(ws + WS_TW); const int j = i - 512; int m, N; if (j < 4096) { m = j; N = 4096; } else if (j < 4352) { m = j - 4096; N = 256; } else { m = j - 4352; N = 64; }
                const double ang = 6.283185307179586476925 * (double)m / (double)N; tw[2 * j] = (float)cos(ang); tw[2 * j + 1] = (float)sin(ang); } }
    }
}
__device__ __forceinline__ void krope_task(unsigned char* lds, int task) { P0_CTX;
    const bf16* H = (const bf16*)(ws + WS_H); const bf16* W = (const bf16*)(ws + WS_WT_IN_E) + (size_t)3072 * 1024; bf16* KR = (bf16*)(ws + WS_KR);
    const float* rope = (const float*)(ws + WS_ROPE); float* st_krope = a->out + (size_t)NTOK * DM + (size_t)NPR * 256;
    const int r32 = lane & 31, hi = lane >> 5, row0 = task * 256 + wave * 32;
    unsigned char* sa = lds + wave * 9216; unsigned char* sw = sa + 4608;
    const int sr = lane >> 3, sc = lane & 7;
    const bf16* ga = H + (size_t)(row0 + sr) * 1024 + sc * 8; const bf16* gw = W + (size_t)sr * 1024 + sc * 8;
    u32x4 ra[4], rw[4];
#pragma unroll
    for (int j = 0; j < 4; ++j) { ra[j] = *(const u32x4*)(ga + j * 8192); rw[j] = *(const u32x4*)(gw + j * 8192); }
    f32x16 acc = {};
#pragma unroll 1
    for (int ch = 0; ch < 16; ++ch) {
#pragma unroll
        for (int j = 0; j < 4; ++j) { *(u32x4*)(sa + (8 * j + sr) * 144 + sc * 16) = ra[j]; *(u32x4*)(sw + (8 * j + sr) * 144 + sc * 16) = rw[j]; }
        if (ch < 15) {
#pragma unroll
            for (int j = 0; j < 4; ++j) { ra[j] = *(const u32x4*)(ga + j * 8192 + (ch + 1) * 64); rw[j] = *(const u32x4*)(gw + j * 8192 + (ch + 1) * 64); } }
#pragma unroll
        for (int ks = 0; ks < 4; ++ks) { const bf16x8 A = *(const bf16x8*)(sa + r32 * 144 + (16 * ks + 8 * hi) * 2), B = *(const bf16x8*)(sw + r32 * 144 + (16 * ks + 8 * hi) * 2);
            acc = __builtin_amdgcn_mfma_f32_32x32x16_bf16(A, B, acc, 0, 0, 0); }
    }
    const bool samp = task >= 16; const int n = r32, fa = n >> 4, fp = (n >> 3) & 1, ff = n & 7;
#pragma unroll
    for (int r = 0; r < 16; ++r) { const int row = row0 + (r & 3) + 8 * (r >> 2) + 4 * hi; float x = acc[r];
        if (!samp) { st_krope[(size_t)row * 32 + n] = x; KR[(size_t)row * 32 + n] = (bf16)f2bf(x); }
        else { const float px = __shfl_xor(x, 8); const int s = row - NPR, t = s & 4095, pos = fa ? (t & 63) : (t >> 6); const float cs = rope[(pos * 8 + ff) * 2], sn = rope[(pos * 8 + ff) * 2 + 1];
            x = fp ? (px * sn + x * cs) : (x * cs - px * sn);
            KR[(size_t)(NPR + (s >> 12) * LKS + PAST + t) * 32 + n] = (bf16)f2bf(x); } }
}
__device__ __forceinline__ void norm_mod_row(const float* __restrict__ xrow, bf16* __restrict__ hrow, const float* __restrict__ g, const float* __restrict__ shift, const float* __restrict__ scale, int lane);
__device__ __forceinline__ void norm0_task(unsigned char* lds, int task) { P0_CTX;
    if (wave == 0) { unsigned spins = 0;
        while ((unsigned)__builtin_amdgcn_readfirstlane((int)__hip_atomic_load((unsigned*)(ws + WS_CTL) + CW_ADA, __ATOMIC_RELAXED, __HIP_MEMORY_SCOPE_AGENT)) < 192u) {
            __builtin_amdgcn_s_sleep(2);
            if (++spins > (1u << 22)) { if (lane == 0) __hip_atomic_store((unsigned*)(ws + WS_CTL) + CW_TMO, 1u, __ATOMIC_RELAXED, __HIP_MEMORY_SCOPE_AGENT); break; } }
        __builtin_amdgcn_fence(__ATOMIC_ACQUIRE, "agent");
        asm volatile("s_waitcnt vmcnt(0)" ::: "memory"); }
    __syncthreads();
    const float* MOD = (const float*)(ws + WS_MOD); const float* g = a->in[I_NORMG]; bf16* H = (bf16*)(ws + WS_H);
    const int r0 = task * 64 + wave * 8; const int cond = r0 < NPR ? 0 : 1 + ((r0 - NPR) >> 12);
#pragma unroll 4
    for (int i = 0; i < 8; ++i) { const int r = r0 + i; const float* xrow = r < NPR ? a->in[I_XP] + (size_t)r * DM : a->in[I_XS] + (size_t)(r - NPR) * DM;
        norm_mod_row(xrow, H + (size_t)r * DM, g, MOD + cond * 3072, MOD + cond * 3072 + 1024, lane); }
}
__device__ __forceinline__ void fnet_fold_task(unsigned char* lds, int task);
__device__ __forceinline__ void drain_segment(unsigned char* lds, const int seg) {
    for (;;) {
        int t;
        { P0_CTX; volatile LAS unsigned* cwl = (volatile LAS unsigned*)((LAS unsigned char*)g_lds + CTXW_OFF);
          __syncthreads();
          if (tid == 0) cwl[70] = __hip_atomic_fetch_add((unsigned*)(ws + WS_CTL) + CW_Q0 + seg, 1u, __ATOMIC_RELAXED, __HIP_MEMORY_SCOPE_AGENT);
          __syncthreads();
          t = __builtin_amdgcn_readfirstlane((int)cwl[70]); }
        if (t >= SEG_N[seg]) break;
        if (seg == 0) { if (t < 192) p0_ada_task(lds, t); else if (t < 256) p0_filter_task(lds, 72 + (t - 192)); else if (t < 259) p0_misc_task(lds, 86 + (t - 256)); else if (t < 579) norm0_task(lds, t - 259);
                        else p0_wt_task(lds, t - 579, 0, 1552); }
        else if (seg == 1) { if (t < 16) p0_pq_task(lds, t); else if (t < 88) p0_filter_task(lds, t - 16); else if (t < 168) krope_task(lds, t - 88); else if (t < 240) p0_misc_task(lds, 14 + (t - 168));
                             else p0_wt_task(lds, t - 240, 1552, 1776); }
        else if (seg == 2) p0_wt_task(lds, t, 1776, 2288);
        else if (seg == 3) { if (t < 256) fnet_fold_task(lds, t); else p0_wt_task(lds, t - 256, 2288, 2800); }
        else p0_wt_task(lds, t, 2800, 3312);
    }
    __syncthreads();
}

__device__ __forceinline__ void norm_mod_row(const float* __restrict__ xrow, bf16* __restrict__ hrow, const float* __restrict__ g, const float* __restrict__ shift, const float* __restrict__ scale, int lane) {
    f32x4 v[4]; float s = 0.f;
#pragma unroll
    for (int j = 0; j < 4; ++j) { v[j] = __builtin_nontemporal_load((const f32x4*)(xrow + 4 * lane + 256 * j)); s += (v[j][0] * v[j][0] + v[j][1] * v[j][1]) + (v[j][2] * v[j][2] + v[j][3] * v[j][3]); }
    const float rs = 1.0f / sqrtf(wave_sum(s) * (1.0f / 1024.0f) + EPS);
#pragma unroll
    for (int j = 0; j < 4; ++j) { const int c = 4 * lane + 256 * j; const f32x4 gg = *(const f32x4*)(g + c), sh = *(const f32x4*)(shift + c), sc = *(const f32x4*)(scale + c);
        const f32x4 h = (v[j] * rs * gg) * (sc + 1.0f) + sh; u32x2 o; o.x = pk2(h[0], h[1]); o.y = pk2(h[2], h[3]); *(u32x2*)(hrow + c) = o; }
}
__device__ __forceinline__ void norm_mod_row_b(const bf16* __restrict__ xrow, bf16* __restrict__ hrow, const float* __restrict__ g, const float* __restrict__ shift, const float* __restrict__ scale, int lane) {
    f32x4 v[4]; float s = 0.f;
#pragma unroll
    for (int j = 0; j < 2; ++j) unpack8(__builtin_nontemporal_load((const u32x4*)(xrow + 8 * lane + 512 * j)), v[2 * j], v[2 * j + 1]);
#pragma unroll
    for (int j = 0; j < 4; ++j) s += (v[j][0] * v[j][0] + v[j][1] * v[j][1]) + (v[j][2] * v[j][2] + v[j][3] * v[j][3]);
    const float rs = 1.0f / sqrtf(wave_sum(s) * (1.0f / 1024.0f) + EPS);
#pragma unroll
    for (int j = 0; j < 2; ++j) { const int c = 8 * lane + 512 * j; f32x4 h[2];
#pragma unroll
        for (int e = 0; e < 2; ++e) { const f32x4 gg = *(const f32x4*)(g + c + 4 * e), sh = *(const f32x4*)(shift + c + 4 * e), sc = *(const f32x4*)(scale + c + 4 * e); h[e] = (v[2 * j + e] * rs * gg) * (sc + 1.0f) + sh; }
        u32x4 o; o.x = pk2(h[0][0], h[0][1]); o.y = pk2(h[0][2], h[0][3]); o.z = pk2(h[1][0], h[1][1]); o.w = pk2(h[1][2], h[1][3]);
        bf16* hp = hrow + c; asm volatile("global_store_dwordx4 %0, %1, off sc1" :: "v"(hp), "v"(o) : "memory"); }
}
__device__ __forceinline__ void fnet_fold_task(unsigned char* lds, int task) { P0_CTX;
    constexpr int WUP = 130, PQP = 160;
    float* wu = (float*)lds;
    float* pq = wu + 64 * WUP;
    const float* PQ = (const float*)(ws + WS_PQ); const float* W = a->in[I_WINO]; bf16* WT = (bf16*)(ws + WS_WT_IN_O);
    const int half = task >> 7, g = (task >> 4) & 7, k0 = (task & 15) * 64;
    for (int i = tid; i < 64 * 128; i += 512) { const int k = i >> 7, c = i & 127; wu[k * WUP + c] = W[(size_t)(k0 + k) * 2048 + g * 128 + c]; }
    for (int i = tid; i < 128 * 128; i += 512) pq[(i >> 7) * PQP + (i & 127)] = PQ[(size_t)(half * 8 + g) * 16384 + i];
    __syncthreads();
    const int r32 = lane & 31, hi = lane >> 5, kb = wave >> 2, db = wave & 3;
    const float* ap = wu + (kb * 32 + r32) * WUP + hi; const float* bp = pq + hi * PQP + db * 32 + r32;
    f32x16 acc = {};
#pragma unroll 16
    for (int kk = 0; kk < 64; ++kk) acc = __builtin_amdgcn_mfma_f32_32x32x2f32(ap[2 * kk], bp[2 * kk * PQP], acc, 0, 0, 0);
    bf16* dst = WT + (size_t)(half * 1024 + g * 128 + db * 32 + r32) * 1024 + k0 + kb * 32 + 4 * hi;
#pragma unroll
    for (int q = 0; q < 4; ++q) { u32x2 o; o.x = pk2(acc[4 * q], acc[4 * q + 1]); o.y = pk2(acc[4 * q + 2], acc[4 * q + 3]); *(u32x2*)(dst + 8 * q) = o; }
}
__device__ __forceinline__ void panel_wait(unsigned* pcw, unsigned* tmo, int wave, int lane) {
    if (wave == 0) { unsigned spins = 0;
        while ((unsigned)__builtin_amdgcn_readfirstlane((int)__hip_atomic_load(pcw, __ATOMIC_RELAXED, __HIP_MEMORY_SCOPE_AGENT)) < 32u) {
            __builtin_amdgcn_s_sleep(2);
            if (++spins > (1u << 22)) { if (lane == 0) __hip_atomic_store(tmo, 1u, __ATOMIC_RELAXED, __HIP_MEMORY_SCOPE_AGENT); break; } }
        __builtin_amdgcn_fence(__ATOMIC_ACQUIRE, "agent");
        asm volatile("s_waitcnt vmcnt(0)" ::: "memory"); }
    __syncthreads();
}
template <bool LAYER1>
__device__ __forceinline__ void panel_queue(unsigned char* lds, const int qw = (LAYER1 ? 5 : 6), const int t0 = 0, const int nt = NTOK / 64) {
    for (;;) {
        int t;
        { P0_CTX; volatile LAS unsigned* cwl = (volatile LAS unsigned*)((LAS unsigned char*)g_lds + CTXW_OFF);
          __syncthreads();
          if (tid == 0) cwl[70] = __hip_atomic_fetch_add((unsigned*)(ws + WS_CTL) + CW_Q0 + qw, 1u, __ATOMIC_RELAXED, __HIP_MEMORY_SCOPE_AGENT);
          __syncthreads();
          t = __builtin_amdgcn_readfirstlane((int)cwl[70]); }
        if (t >= nt) break;
        t += t0;
        P0_CTX; const int pnl = t >> 2;
        panel_wait((unsigned*)(ws + WS_CTL) + (LAYER1 ? CW_PC5 : CW_PC10) + 64 * pnl, (unsigned*)(ws + WS_CTL) + CW_TMO, wave, lane);
        if (LAYER1) {
            const float* MOD = (const float*)(ws + WS_MOD) + 5 * 3072; const float* g = a->in[I_NORMG] + 1024; bf16* H = (bf16*)(ws + WS_H);
            const int cond = pnl < 16 ? 0 : 1 + ((pnl - 16) >> 4);
#pragma unroll 4
            for (int i = 0; i < 8; ++i) { const int r = t * 64 + wave * 8 + i; norm_mod_row_b(x1b_tile(ws, a->out, pnl) + (size_t)(r & 255) * DM, H + (size_t)r * DM, g, MOD + cond * 3072, MOD + cond * 3072 + 1024, lane); }
            asm volatile("s_waitcnt vmcnt(0)" ::: "memory");
            if (lane == 0) __hip_atomic_fetch_add((unsigned*)(ws + WS_CTL) + CW_PR + 64 * pnl, 1u, __ATOMIC_RELAXED, __HIP_MEMORY_SCOPE_AGENT);
        } else {
            const float* g = a->in[I_FINALG]; const bf16* X2B = (const bf16*)(ws + WS_X2B);
#pragma unroll 4
            for (int i = 0; i < 8; ++i) { const int r = t * 64 + wave * 8 + i; float* y = a->out + (size_t)r * DM; f32x4 v[4]; float s = 0.f;
#pragma unroll
                for (int j = 0; j < 2; ++j) unpack8(__builtin_nontemporal_load((const u32x4*)(X2B + (size_t)r * DM + 8 * lane + 512 * j)), v[2 * j], v[2 * j + 1]);
#pragma unroll
                for (int j = 0; j < 4; ++j) s += (v[j][0] * v[j][0] + v[j][1] * v[j][1]) + (v[j][2] * v[j][2] + v[j][3] * v[j][3]);
                const float rs = 1.0f / sqrtf(wave_sum(s) * (1.0f / 1024.0f) + EPS);
#pragma unroll
                for (int j = 0; j < 4; ++j) { const int cc = 8 * lane + 512 * (j >> 1) + 4 * (j & 1); *(f32x4*)(y + cc) = v[j] * rs * *(const f32x4*)(g + cc); } }
        }
    }
    __syncthreads();
}
__device__ __forceinline__ void state_fix_phase(ArgsP a, int tid, int bid, int G) {
    float* st = a->out + (size_t)NTOK * DM; const float* ssq = (const float*)(a->ws + WS_SSQKV);
    for (int i = bid * 512 + tid; i < NPR * 256 / 4; i += G * 512) { const int r = i >> 6; const f32x4 s4 = *(const f32x4*)(ssq + (size_t)r * 4);
        const float rs = 1.0f / sqrtf(((s4[0] + s4[1]) + (s4[2] + s4[3])) * (1.0f / 256.0f) + EPS); f32x4* p = (f32x4*)st + i; *p = *p * rs; }
}

template <bool SAMPLE> struct HyCfg;
template <> struct HyCfg<true>  { static constexpr int L = LSM, NB = 4,  NCH = 1, CPP = 16448, ZB = 7, NBLK = 78, VBATCH = 11328, VOFF = 4 * 16448, CHB = 4 * 16448 + 4 * 11328, TMP = CHB, MISC = TMP + 2 * LSM * 2, TOK0 = NPR; };
template <> struct HyCfg<false> { static constexpr int L = LPR, NB = 16, NCH = 4, CPP = 1088,  ZB = 1, NBLK = 6,  VBATCH = 864,   VOFF = 4 * 1088,  CHB = 4 * 1088 + 16 * 864,   TMP = 4 * CHB, MISC = TMP + 4 * 2 * LPR * 2, TOK0 = 0; };
constexpr int HY_BLK = 144;
template <bool SAMPLE>
__device__ __forceinline__ void hyena_mfma_unit(ArgsP a, unsigned char* lds, int unit, int tid, int lane, int wave) {
    typedef HyCfg<SAMPLE> C; constexpr int L = C::L, NB = C::NB, NCH = C::NCH;
    const int c0 = unit * NCH;
    const bf16* UT = (const bf16*)(a->ws + WS_UT); bf16* YT = (bf16*)(a->ws + WS_YT);
    const bf16* KF = (const bf16*)(a->ws + (SAMPLE ? WS_KF0 : WS_KF1));
    const float* cw = a->in[I_CONVW]; const float* cb = a->in[I_CONVB];
    float* misc = (float*)(lds + C::MISC);
    __syncthreads();
    if (wave < NCH) { const float* PS = (const float*)(a->ws + WS_PS) + (size_t)(SAMPLE ? 0 : 256) * 1024; const int c = c0 + wave; float s = 0.f;
        for (int ch = lane; ch < L / 32; ch += 64) s += PS[(size_t)ch * 1024 + c] + PS[(size_t)ch * 1024 + 512 + c];
        s = wave_sum(s); if (lane == 0) misc[wave] = 1.0f / s; }
#pragma unroll
    for (int it = 0; it < (NCH * 2 * L / 8 + 511) / 512; ++it) { const int q = tid + it * 512; if (q < NCH * 2 * L / 8) *(u32x4*)(lds + C::TMP + 16 * q) = *(const u32x4*)(KF + (size_t)c0 * (2 * L) + 8 * q); }
    __syncthreads();
    { constexpr int QPC = (2 * L + 8) / 8;
      for (int ch = tid; ch < NCH * 4 * QPC; ch += 512) { const int cc = ch / (4 * QPC), rem = ch - cc * (4 * QPC), sg = rem / QPC, q = rem - sg * QPC, T = 2 * L - 8 * q - sg; unsigned w[4];
          const bf16* tmp = (const bf16*)(lds + C::TMP) + cc * (2 * L);
#pragma unroll
          for (int e2 = 0; e2 < 4; ++e2) { const int i0 = T - 2 * e2, i1 = i0 - 1;
              const unsigned lo = (i0 >= 0 && i0 < 2 * L) ? (unsigned)tmp[i0] : 0u, hi = (i1 >= 0 && i1 < 2 * L) ? (unsigned)tmp[i1] : 0u; w[e2] = lo | (hi << 16); }
          *(u32x4*)(lds + cc * C::CHB + sg * C::CPP + 16 * q) = (u32x4){w[0], w[1], w[2], w[3]}; } }
    {
#pragma unroll 2
        for (int it = 0; it < NCH * NB * L / 8 / 512; ++it) { const int ch = tid + it * 512, cc = ch / (NB * L / 8), rem = ch - cc * (NB * L / 8), b = rem / (L / 8), s0 = (rem - b * (L / 8)) * 8, tok = C::TOK0 + b * L + s0; const int c = c0 + cc;
            const bf16* r1 = UT + (size_t)(512 + c) * NTOK; const bf16* rv = UT + (size_t)(1024 + c) * NTOK;
            const float a0 = cw[512 + c], a1 = cw[1536 + 512 + c], a2 = cw[3072 + 512 + c], ab = cb[512 + c];
            const float v0 = cw[1024 + c], v1 = cw[1536 + 1024 + c], v2 = cw[3072 + 1024 + c], vb = cb[1024 + c];
            const u32x4 xa = *(const u32x4*)(r1 + tok), xv = *(const u32x4*)(rv + tok);
            float fa[10], fv[10];
            fa[0] = s0 > 0 ? bf2f(r1[tok - 1]) : 0.f; fv[0] = s0 > 0 ? bf2f(rv[tok - 1]) : 0.f;
            fa[9] = s0 + 8 < L ? bf2f(r1[tok + 8]) : 0.f; fv[9] = s0 + 8 < L ? bf2f(rv[tok + 8]) : 0.f;
#pragma unroll
            for (int e = 0; e < 4; ++e) { fa[1 + 2 * e] = bf2f(xa[e] & 0xffffu); fa[2 + 2 * e] = bf2f(xa[e] >> 16); fv[1 + 2 * e] = bf2f(xv[e] & 0xffffu); fv[2 + 2 * e] = bf2f(xv[e] >> 16); }
            unsigned w[4];
#pragma unroll
            for (int e = 0; e < 4; ++e) { const float p0 = (vb + v0 * fv[2 * e] + v1 * fv[2 * e + 1] + v2 * fv[2 * e + 2]) * (ab + a0 * fa[2 * e] + a1 * fa[2 * e + 1] + a2 * fa[2 * e + 2]);
                const float p1 = (vb + v0 * fv[2 * e + 1] + v1 * fv[2 * e + 2] + v2 * fv[2 * e + 3]) * (ab + a0 * fa[2 * e + 1] + a1 * fa[2 * e + 2] + a2 * fa[2 * e + 3]); w[e] = pk2(p0, p1); }
            *(u32x4*)(lds + cc * C::CHB + C::VOFF + b * C::VBATCH + ((s0 >> 6) + C::ZB) * HY_BLK + 2 * (s0 & 63)) = (u32x4){w[0], w[1], w[2], w[3]}; }
        constexpr int NZ = NCH * NB * 2 * C::ZB * 9;
        for (int z = tid; z < NZ; z += 512) { const int cc = z / (NB * 2 * C::ZB * 9), rem = z - cc * (NB * 2 * C::ZB * 9), b = rem / (2 * C::ZB * 9), rr = rem - b * (2 * C::ZB * 9), blk = rr / 9, part = rr - blk * 9;
            *(u32x4*)(lds + cc * C::CHB + C::VOFF + b * C::VBATCH + (blk < C::ZB ? blk : L / 64 + blk) * HY_BLK + 16 * part) = (u32x4){0u, 0u, 0u, 0u}; }
    }
    __syncthreads();
    const int r = lane & 31, h = lane >> 5, sg = (4 - (r & 3)) & 3;
    const int cc = SAMPLE ? 0 : (wave >> 1), c = c0 + cc;
    const int I = SAMPLE ? 8 * wave + (r >> 2) : 2 * (wave & 1) + (r >> 4), b = SAMPLE ? (r & 3) : (r & 15);
    const int dlo = SAMPLE ? 8 * wave - 63 : 2 * (wave & 1) - 3, dhi = SAMPLE ? 8 * wave + 7 : 2 * (wave & 1) + 1;
    const float sinv = misc[cc], skip = a->in[I_SKIP][c];
    const unsigned char* chb = lds + cc * C::CHB;
    const unsigned char* abase = chb + sg * C::CPP + 2 * (L - r + 8 * h - sg);
    const unsigned char* bbase = chb + C::VOFF + b * C::VBATCH + (I + C::ZB) * HY_BLK + 16 * h;
    f32x16 acc0 = {}, acc1 = {};
    u32x2 W[6][2], Wn[4][2]; bf16x8 Bf[4], Bn[4];
    { const unsigned char* ap = abase - 32 * (4 * dlo - 3); const unsigned char* bp = bbase - HY_BLK * dlo;
#pragma unroll
      for (int k = 0; k < 2; ++k) { W[k][0] = *(const u32x2*)(ap - 32 * k); W[k][1] = *(const u32x2*)(ap - 32 * k + 8); }
#pragma unroll
      for (int k = 2; k < 6; ++k) { Wn[k - 2][0] = *(const u32x2*)(ap - 32 * k); Wn[k - 2][1] = *(const u32x2*)(ap - 32 * k + 8); }
#pragma unroll
      for (int kj = 0; kj < 4; ++kj) Bn[kj] = *(const bf16x8*)(bp + 32 * kj); }
#pragma unroll 1
    for (int d = dlo; d <= dhi; ++d) {
#pragma unroll
        for (int k = 0; k < 4; ++k) { W[k + 2][0] = Wn[k][0]; W[k + 2][1] = Wn[k][1]; Bf[k] = Bn[k]; }
        if (d < dhi) {
            const unsigned char* ap = abase - 32 * (4 * (d + 1) - 3); const unsigned char* bp = bbase - HY_BLK * (d + 1);
#pragma unroll
            for (int k = 2; k < 6; ++k) { Wn[k - 2][0] = *(const u32x2*)(ap - 32 * k); Wn[k - 2][1] = *(const u32x2*)(ap - 32 * k + 8); }
#pragma unroll
            for (int kj = 0; kj < 4; ++kj) Bn[kj] = *(const bf16x8*)(bp + 32 * kj);
        }
#pragma unroll
        for (int kj = 0; kj < 4; ++kj) {
            const bf16x8 A0 = __builtin_bit_cast(bf16x8, (u32x4){W[3 - kj][0].x, W[3 - kj][0].y, W[3 - kj][1].x, W[3 - kj][1].y});
            const bf16x8 A1 = __builtin_bit_cast(bf16x8, (u32x4){W[5 - kj][0].x, W[5 - kj][0].y, W[5 - kj][1].x, W[5 - kj][1].y});
            acc0 = __builtin_amdgcn_mfma_f32_32x32x16_bf16(A0, Bf[kj], acc0, 0, 0, 0);
            acc1 = __builtin_amdgcn_mfma_f32_32x32x16_bf16(A1, Bf[kj], acc1, 0, 0, 0);
        }
        W[0][0] = W[4][0]; W[0][1] = W[4][1]; W[1][0] = W[5][0]; W[1][1] = W[5][1];
    }
    {
        const bf16* r0 = UT + (size_t)c * NTOK + C::TOK0 + b * L; const bf16* rg = UT + (size_t)(1536 + c) * NTOK + C::TOK0 + b * L; bf16* yo = YT + (size_t)c * NTOK + C::TOK0 + b * L;
        const float x0w0 = cw[c], x0w1 = cw[1536 + c], x0w2 = cw[3072 + c], x0b = cb[c];
#pragma unroll
        for (int mi = 0; mi < 2; ++mi)
#pragma unroll
            for (int g = 0; g < 4; ++g) { const int i0 = 32 * mi + 8 * g + 4 * h, t0 = 64 * I + i0;
                const u32x2 vv = *(const u32x2*)(chb + C::VOFF + b * C::VBATCH + (I + C::ZB) * HY_BLK + 2 * i0);
                const u32x2 xx = *(const u32x2*)(r0 + t0), gg = *(const u32x2*)(rg + t0);
                float fx[6]; fx[0] = t0 > 0 ? bf2f(r0[t0 - 1]) : 0.f; fx[5] = t0 + 4 < L ? bf2f(r0[t0 + 4]) : 0.f;
                fx[1] = bf2f(xx.x & 0xffffu); fx[2] = bf2f(xx.x >> 16); fx[3] = bf2f(xx.y & 0xffffu); fx[4] = bf2f(xx.y >> 16);
                const float fvv[4] = {bf2f(vv.x & 0xffffu), bf2f(vv.x >> 16), bf2f(vv.y & 0xffffu), bf2f(vv.y >> 16)};
                const float fg[4] = {bf2f(gg.x & 0xffffu), bf2f(gg.x >> 16), bf2f(gg.y & 0xffffu), bf2f(gg.y >> 16)};
                float y[4];
#pragma unroll
                for (int e = 0; e < 4; ++e) { const float av = mi == 0 ? acc0[4 * g + e] : acc1[4 * g + e];
                    y[e] = (av * sinv + fvv[e] * skip) * (x0b + x0w0 * fx[e] + x0w1 * fx[e + 1] + x0w2 * fx[e + 2]) * fg[e]; }
                *(u32x2*)(yo + t0) = (u32x2){pk2(y[0], y[1]), pk2(y[2], y[3])}; }
    }
}

__device__ __forceinline__ int crow(int r, int hi) { return (r & 3) + 8 * (r >> 2) + 4 * hi; }
constexpr float ATT_THR = 8.0f;
constexpr int KS_PITCH = 104, VS_PITCH = 68;
constexpr int ATT_KS = 0, ATT_VS = 2 * 64 * KS_PITCH * 2, ATT_ST = ATT_VS + 2 * 64 * VS_PITCH * 2, ATT_ST_PITCH = 72;
template <bool FAST>
__device__ __forceinline__ bool attn_unit(ArgsP a, unsigned char* lds, int qrow0, int nact, int kvrow0, int Lk, int h, int lane, int wave) {
    asm volatile("" : "+v"(lane)); const int tid = wave * 64 + lane;
    const bf16* Q = (const bf16*)(a->ws + WS_Q); const bf16* KN = (const bf16*)(a->ws + WS_KN); const bf16* KR = (const bf16*)(a->ws + WS_KR);
    const bf16* VT = (const bf16*)(a->ws + WS_VT); const bf16* SGB = (const bf16*)(a->ws + WS_SGB); bf16* Z = (bf16*)(a->ws + WS_Z);
    bf16* Ks = (bf16*)(lds + ATT_KS); bf16* Vs = (bf16*)(lds + ATT_VS); bf16* St = (bf16*)(lds + ATT_ST) + wave * 32 * ATT_ST_PITCH;
    const int r32 = lane & 31, hi = lane >> 5; const bool act = wave < nact;
    bf16x8 qf[2][6];
    { const bf16* qp = Q + (size_t)(qrow0 + (act ? wave : 0) * 64 + r32) * 768 + h * 96 + 8 * hi;
#pragma unroll
        for (int qa = 0; qa < 2; ++qa)
#pragma unroll
            for (int ks = 0; ks < 6; ++ks) qf[qa][ks] = *(const bf16x8*)(qp + (size_t)qa * 32 * 768 + 16 * ks); }
    const int kkey = tid >> 3, kch = tid & 7;
    const int rkey = tid >> 2, rch = tid & 3;
    const int vd = tid >> 3, vch = tid & 7;
    const bf16* kn_src = KN + (size_t)(kvrow0 + kkey) * 512 + h * 64 + kch * 8;
    const bf16* kr_src = KR + (size_t)(kvrow0 + (rkey & 63)) * 32 + rch * 8;
    const bf16* vt_src = VT + (size_t)(h * 64 + vd) * NKV + kvrow0 + vch * 8;
    const int NT = Lk / 64;
    u32x4 kreg, rreg, vreg;
    kreg = *(const u32x4*)kn_src; rreg = (wave < 4) ? *(const u32x4*)kr_src : (u32x4){0u, 0u, 0u, 0u}; vreg = *(const u32x4*)vt_src;
    __syncthreads();
    { *(u32x4*)(Ks + kkey * KS_PITCH + kch * 8) = kreg; if (wave < 4) *(u32x4*)(Ks + rkey * KS_PITCH + 64 + rch * 8) = rreg;
      u32x2* vp = (u32x2*)(Vs + vd * VS_PITCH + vch * 8); vp[0] = (u32x2){vreg.x, vreg.y}; vp[1] = (u32x2){vreg.z, vreg.w}; }
    __syncthreads();
    float mhat[2] = {0.f, 0.f}, l_run[2] = {0.f, 0.f}; f32x16 o[2][2] = {};
#define ATT_TILE_MAX(j) do { \
        const int buf = j & 1; \
        if (j + 1 < NT) { kreg = *(const u32x4*)(kn_src + (size_t)(j + 1) * 64 * 512); if (wave < 4) rreg = *(const u32x4*)(kr_src + (size_t)(j + 1) * 64 * 32); vreg = *(const u32x4*)(vt_src + (j + 1) * 64); } \
        if (act) { \
            const bf16* kb = Ks + buf * 64 * KS_PITCH; const bf16* vb = Vs + buf * 64 * VS_PITCH; \
            f32x16 s[2][2]; \
        _Pragma("unroll") \
            for (int qa = 0; qa < 2; ++qa) { const float nm = -mhat[qa]; \
        _Pragma("unroll") \
                for (int r = 0; r < 16; ++r) { s[qa][0][r] = nm; s[qa][1][r] = nm; } } \
        _Pragma("unroll") \
            for (int ks = 0; ks < 6; ++ks) { const bf16x8 a0 = *(const bf16x8*)(kb + r32 * KS_PITCH + 16 * ks + 8 * hi), a1 = *(const bf16x8*)(kb + (32 + r32) * KS_PITCH + 16 * ks + 8 * hi); \
                s[0][0] = __builtin_amdgcn_mfma_f32_32x32x16_bf16(a0, qf[0][ks], s[0][0], 0, 0, 0); s[0][1] = __builtin_amdgcn_mfma_f32_32x32x16_bf16(a1, qf[0][ks], s[0][1], 0, 0, 0); \
                s[1][0] = __builtin_amdgcn_mfma_f32_32x32x16_bf16(a0, qf[1][ks], s[1][0], 0, 0, 0); s[1][1] = __builtin_amdgcn_mfma_f32_32x32x16_bf16(a1, qf[1][ks], s[1][1], 0, 0, 0); \
                asm volatile("" ::: "memory"); } \
            float mx[2]; \
        _Pragma("unroll") \
            for (int qa = 0; qa < 2; ++qa) { const f32x16& t0 = s[qa][0]; const f32x16& t1 = s[qa][1]; \
                float mxa = fmaxf(fmaxf(t0[0], t0[1]), t1[0]), mxb = fmaxf(fmaxf(t0[2], t0[3]), t1[1]); \
                mxa = fmaxf(fmaxf(mxa, t1[2]), t1[3]); \
        _Pragma("unroll") \
                for (int r = 4; r < 16; r += 4) { mxa = fmaxf(fmaxf(mxa, t0[r]), t0[r + 1]); mxb = fmaxf(fmaxf(mxb, t0[r + 2]), t0[r + 3]); mxa = fmaxf(fmaxf(mxa, t1[r]), t1[r + 1]); mxb = fmaxf(fmaxf(mxb, t1[r + 2]), t1[r + 3]); } \
                const float m1 = fmaxf(mxa, mxb); mx[qa] = fmaxf(m1, __shfl_xor(m1, 32)); } \
            const bool first = (j == 0); \
            if (first || __any(fmaxf(mx[0], mx[1]) > ATT_THR)) { \
                int hi2 = hi; asm volatile("" : "+v"(hi2)); \
        _Pragma("unroll") \
                for (int qa = 0; qa < 2; ++qa) { const float dl = first ? mx[qa] : fmaxf(mx[qa], 0.f); mhat[qa] += dl; \
        _Pragma("unroll") \
                    for (int r = 0; r < 16; ++r) { s[qa][0][r] -= dl; s[qa][1][r] -= dl; } \
                    if (!first) { const float alpha = __builtin_amdgcn_exp2f(-dl); l_run[qa] *= alpha; \
        _Pragma("unroll") \
                        for (int r = 0; r < 16; ++r) { const float ar = __shfl(alpha, crow(r, hi2)); o[qa][0][r] *= ar; o[qa][1][r] *= ar; } } } \
            } \
            bf16x8 pa[2][4]; \
        _Pragma("unroll") \
            for (int qa = 0; qa < 2; ++qa) { float ps = 0.f, ps2 = 0.f; \
        _Pragma("unroll") \
                for (int r = 0; r < 16; ++r) { s[qa][0][r] = __builtin_amdgcn_exp2f(s[qa][0][r]); s[qa][1][r] = __builtin_amdgcn_exp2f(s[qa][1][r]); ps += s[qa][0][r]; ps2 += s[qa][1][r]; } \
                l_run[qa] += ps + ps2; \
        _Pragma("unroll") \
                for (int s2 = 0; s2 < 2; ++s2) { \
                    u32x4 w0, w1; \
                    w0.x = pg8::cvt_pk_bf16(s[qa][0][8 * s2 + 0], s[qa][0][8 * s2 + 1]); w0.y = pg8::cvt_pk_bf16(s[qa][0][8 * s2 + 2], s[qa][0][8 * s2 + 3]); w0.z = pg8::cvt_pk_bf16(s[qa][0][8 * s2 + 4], s[qa][0][8 * s2 + 5]); w0.w = pg8::cvt_pk_bf16(s[qa][0][8 * s2 + 6], s[qa][0][8 * s2 + 7]); \
                    w1.x = pg8::cvt_pk_bf16(s[qa][1][8 * s2 + 0], s[qa][1][8 * s2 + 1]); w1.y = pg8::cvt_pk_bf16(s[qa][1][8 * s2 + 2], s[qa][1][8 * s2 + 3]); w1.z = pg8::cvt_pk_bf16(s[qa][1][8 * s2 + 4], s[qa][1][8 * s2 + 5]); w1.w = pg8::cvt_pk_bf16(s[qa][1][8 * s2 + 6], s[qa][1][8 * s2 + 7]); \
                    pa[qa][s2] = __builtin_bit_cast(bf16x8, w0); pa[qa][2 + s2] = __builtin_bit_cast(bf16x8, w1); } } \
        _Pragma("unroll") \
            for (int kk = 0; kk < 4; ++kk) { \
                const int base = 16 * kk + 4 * hi; \
                const u32x2 l0 = *(const u32x2*)(vb + r32 * VS_PITCH + base), h0 = *(const u32x2*)(vb + r32 * VS_PITCH + base + 8); \
                const u32x2 l1 = *(const u32x2*)(vb + (32 + r32) * VS_PITCH + base), h1 = *(const u32x2*)(vb + (32 + r32) * VS_PITCH + base + 8); \
                const bf16x8 vf0 = __builtin_bit_cast(bf16x8, (u32x4){l0.x, l0.y, h0.x, h0.y}), vf1 = __builtin_bit_cast(bf16x8, (u32x4){l1.x, l1.y, h1.x, h1.y}); \
                o[0][0] = __builtin_amdgcn_mfma_f32_32x32x16_bf16(pa[0][kk], vf0, o[0][0], 0, 0, 0); o[0][1] = __builtin_amdgcn_mfma_f32_32x32x16_bf16(pa[0][kk], vf1, o[0][1], 0, 0, 0); \
                o[1][0] = __builtin_amdgcn_mfma_f32_32x32x16_bf16(pa[1][kk], vf0, o[1][0], 0, 0, 0); o[1][1] = __builtin_amdgcn_mfma_f32_32x32x16_bf16(pa[1][kk], vf1, o[1][1], 0, 0, 0); \
                asm volatile("" ::: "memory"); \
            } \
        } \
        if (j + 1 < NT) { bf16* kd = Ks + (buf ^ 1) * 64 * KS_PITCH; bf16* vd2 = Vs + (buf ^ 1) * 64 * VS_PITCH; \
            *(u32x4*)(kd + kkey * KS_PITCH + kch * 8) = kreg; if (wave < 4) *(u32x4*)(kd + rkey * KS_PITCH + 64 + rch * 8) = rreg; \
            u32x2* vp = (u32x2*)(vd2 + vd * VS_PITCH + vch * 8); vp[0] = (u32x2){vreg.x, vreg.y}; vp[1] = (u32x2){vreg.z, vreg.w}; } \
        __syncthreads(); \
    } while (0)
#define ATT_TILE_FAST(j) do { \
        const int buf = j & 1; \
        if (j + 1 < NT) { kreg = *(const u32x4*)(kn_src + (size_t)(j + 1) * 64 * 512); if (wave < 4) rreg = *(const u32x4*)(kr_src + (size_t)(j + 1) * 64 * 32); vreg = *(const u32x4*)(vt_src + (j + 1) * 64); } \
        if (act) { \
            const bf16* kb = Ks + buf * 64 * KS_PITCH; const bf16* vb = Vs + buf * 64 * VS_PITCH; \
            f32x16 s[2][2] = {}; \
            bf16x8 ka[3][2]; \
        _Pragma("unroll") \
            for (int ks = 0; ks < 2; ++ks) { ka[ks][0] = *(const bf16x8*)(kb + r32 * KS_PITCH + 16 * ks + 8 * hi); ka[ks][1] = *(const bf16x8*)(kb + (32 + r32) * KS_PITCH + 16 * ks + 8 * hi); } \
        _Pragma("unroll") \
            for (int ks = 0; ks < 6; ++ks) { \
                if (ks + 2 < 6) { ka[(ks + 2) % 3][0] = *(const bf16x8*)(kb + r32 * KS_PITCH + 16 * (ks + 2) + 8 * hi); ka[(ks + 2) % 3][1] = *(const bf16x8*)(kb + (32 + r32) * KS_PITCH + 16 * (ks + 2) + 8 * hi); } \
                const bf16x8 a0 = ka[ks % 3][0], a1 = ka[ks % 3][1]; \
                s[0][0] = __builtin_amdgcn_mfma_f32_32x32x16_bf16(a0, qf[0][ks], s[0][0], 0, 0, 0); s[0][1] = __builtin_amdgcn_mfma_f32_32x32x16_bf16(a1, qf[0][ks], s[0][1], 0, 0, 0); \
                s[1][0] = __builtin_amdgcn_mfma_f32_32x32x16_bf16(a0, qf[1][ks], s[1][0], 0, 0, 0); s[1][1] = __builtin_amdgcn_mfma_f32_32x32x16_bf16(a1, qf[1][ks], s[1][1], 0, 0, 0); \
                } \
            bf16x8 pa[2][4]; \
        _Pragma("unroll") \
            for (int qa = 0; qa < 2; ++qa) { float ps = 0.f, ps2 = 0.f; \
        _Pragma("unroll") \
                for (int r = 0; r < 16; ++r) { s[qa][0][r] = __builtin_amdgcn_exp2f(s[qa][0][r]); s[qa][1][r] = __builtin_amdgcn_exp2f(s[qa][1][r]); ps += s[qa][0][r]; ps2 += s[qa][1][r]; } \
                l_run[qa] += ps + ps2; \
        _Pragma("unroll") \
                for (int s2 = 0; s2 < 2; ++s2) { \
                    u32x4 w0, w1; \
                    w0.x = pg8::cvt_pk_bf16(s[qa][0][8 * s2 + 0], s[qa][0][8 * s2 + 1]); w0.y = pg8::cvt_pk_bf16(s[qa][0][8 * s2 + 2], s[qa][0][8 * s2 + 3]); w0.z = pg8::cvt_pk_bf16(s[qa][0][8 * s2 + 4], s[qa][0][8 * s2 + 5]); w0.w = pg8::cvt_pk_bf16(s[qa][0][8 * s2 + 6], s[qa][0][8 * s2 + 7]); \
                    w1.x = pg8::cvt_pk_bf16(s[qa][1][8 * s2 + 0], s[qa][1][8 * s2 + 1]); w1.y = pg8::cvt_pk_bf16(s[qa][1][8 * s2 + 2], s[qa][1][8 * s2 + 3]); w1.z = pg8::cvt_pk_bf16(s[qa][1][8 * s2 + 4], s[qa][1][8 * s2 + 5]); w1.w = pg8::cvt_pk_bf16(s[qa][1][8 * s2 + 6], s[qa][1][8 * s2 + 7]); \
                    pa[qa][s2] = __builtin_bit_cast(bf16x8, w0); pa[qa][2 + s2] = __builtin_bit_cast(bf16x8, w1); } } \
        _Pragma("unroll") \
            for (int kk = 0; kk < 4; ++kk) { \
                const int base = 16 * kk + 4 * hi; \
                const u32x2 l0 = *(const u32x2*)(vb + r32 * VS_PITCH + base), h0 = *(const u32x2*)(vb + r32 * VS_PITCH + base + 8); \
                const u32x2 l1 = *(const u32x2*)(vb + (32 + r32) * VS_PITCH + base), h1 = *(const u32x2*)(vb + (32 + r32) * VS_PITCH + base + 8); \
                const bf16x8 vf0 = __builtin_bit_cast(bf16x8, (u32x4){l0.x, l0.y, h0.x, h0.y}), vf1 = __builtin_bit_cast(bf16x8, (u32x4){l1.x, l1.y, h1.x, h1.y}); \
                o[0][0] = __builtin_amdgcn_mfma_f32_32x32x16_bf16(pa[0][kk], vf0, o[0][0], 0, 0, 0); o[0][1] = __builtin_amdgcn_mfma_f32_32x32x16_bf16(pa[0][kk], vf1, o[0][1], 0, 0, 0); \
                o[1][0] = __builtin_amdgcn_mfma_f32_32x32x16_bf16(pa[1][kk], vf0, o[1][0], 0, 0, 0); o[1][1] = __builtin_amdgcn_mfma_f32_32x32x16_bf16(pa[1][kk], vf1, o[1][1], 0, 0, 0); \
                \
            } \
        } \
        if (j + 1 < NT) { bf16* kd = Ks + (buf ^ 1) * 64 * KS_PITCH; bf16* vd2 = Vs + (buf ^ 1) * 64 * VS_PITCH; \
            *(u32x4*)(kd + kkey * KS_PITCH + kch * 8) = kreg; if (wave < 4) *(u32x4*)(kd + rkey * KS_PITCH + 64 + rch * 8) = rreg; \
            u32x2* vp = (u32x2*)(vd2 + vd * VS_PITCH + vch * 8); vp[0] = (u32x2){vreg.x, vreg.y}; vp[1] = (u32x2){vreg.z, vreg.w}; } \
        __syncthreads(); \
    } while (0)
    if (FAST) {
#pragma unroll 1
        for (int j = 0; j < NT; ++j) ATT_TILE_FAST(j);
    } else {
#pragma unroll 1
        for (int j = 0; j < NT; ++j) ATT_TILE_MAX(j);
    }
#undef ATT_TILE_MAX
#undef ATT_TILE_FAST
    bool bad = false;
    if (act) {
        int lane3 = lane; asm volatile("" : "+v"(lane3)); const int r32e = lane3 & 31, hie = lane3 >> 5;
#pragma unroll
        for (int qa = 0; qa < 2; ++qa) {
            const float lt = l_run[qa] + __shfl_xor(l_run[qa], 32); const float inv = 1.0f / lt; bad |= !(lt > 1e-30f && lt < 1e30f);
#pragma unroll
            for (int r = 0; r < 16; ++r) { const int q = crow(r, hie); const float ir = __shfl(inv, q);
                St[q * ATT_ST_PITCH + r32e] = (bf16)f2bf(o[qa][0][r] * ir); St[q * ATT_ST_PITCH + 32 + r32e] = (bf16)f2bf(o[qa][1][r] * ir); }
            __builtin_amdgcn_s_waitcnt(0xc07f); asm volatile("" ::: "memory");
#pragma unroll
            for (int it = 0; it < 4; ++it) { const int q = it * 8 + (lane3 >> 3), ch = lane3 & 7; const int row = qrow0 + wave * 64 + qa * 32 + q;
                const u32x4 ov = *(const u32x4*)(St + q * ATT_ST_PITCH + ch * 8); const u32x4 gv = __builtin_nontemporal_load((const u32x4*)(SGB + (size_t)row * 512 + h * 64 + ch * 8));
                u32x4 res;
#pragma unroll
                for (int e = 0; e < 4; ++e) { const unsigned ow = ov[e], gw = gv[e];
                    res[e] = pk2(bf2f(ow & 0xffffu) * bf2f(gw & 0xffffu), bf2f(ow >> 16) * bf2f(gw >> 16)); }
                *(u32x4*)(Z + (size_t)row * DM + 512 + h * 64 + ch * 8) = res; }
            __builtin_amdgcn_s_waitcnt(0xc07f); asm volatile("" ::: "memory");
        }
    }
    if (!FAST) return false;
    volatile LAS unsigned* cwl = (volatile LAS unsigned*)((LAS unsigned char*)g_lds + CTXW_OFF);
    if (__any(bad) && lane == 0) cwl[71] = 1u;
    __syncthreads();
    const bool anybad = __builtin_amdgcn_readfirstlane((int)cwl[71]) != 0;
    __syncthreads();
    if (wave == 0 && lane == 0) cwl[71] = 0u;
    return anybad;
}
__device__ __forceinline__ void attn_phase(ArgsP a, unsigned char* lds, int tid, int lane, int wave, int vcu, int G) {
    for (int su = vcu; su < 256; su += G) { const int b = su >> 6, h = (su >> 3) & 7, qb = su & 7;
        if (attn_unit<true>(a, lds, NPR + b * LSM + qb * 512, 8, NPR + b * LKS, LKS, h, lane, wave)) attn_unit<false>(a, lds, NPR + b * LSM + qb * 512, 8, NPR + b * LKS, LKS, h, lane, wave); }
    for (int pu = vcu; pu < 128; pu += G) { const int b = pu >> 3, h = pu & 7;
        if (attn_unit<true>(a, lds, b * LPR, 4, b * LPR, LPR, h, lane, wave)) attn_unit<false>(a, lds, b * LPR, 4, b * LPR, LPR, h, lane, wave); }
}
__device__ __forceinline__ void transpose_yt_phase(ArgsP a, unsigned char* lds, int lane, int wave, int bid, int G) {
    const bf16* YT = (const bf16*)(a->ws + WS_YT); bf16* Z = (bf16*)(a->ws + WS_Z);
    bf16* scr = (bf16*)lds + wave * (64 * 66);
    const int vcu_ = (G % 8 == 0) ? (bid % 8) * (G / 8) + bid / 8 : bid; const bool half_ = (G == 256);
    const int gw = half_ ? (vcu_ - 128) * NWAVES + wave : bid * NWAVES + wave, NGW = half_ ? 128 * NWAVES : G * NWAVES;
    __syncthreads();
    for (int it = (gw >= 0 ? gw : 8 * 320); it < 8 * 320; it += NGW) { const int c0 = (it & 7) * 64, t0 = (it >> 3) * 64;
#pragma unroll
        for (int i = 0; i < 8; ++i) { const int c = i * 8 + (lane >> 3), ch = lane & 7; const u32x4 v = __builtin_nontemporal_load((const u32x4*)(YT + (size_t)(c0 + c) * NTOK + t0 + ch * 8));
#pragma unroll
            for (int e = 0; e < 4; ++e) { scr[(ch * 8 + 2 * e) * 66 + c] = (bf16)(v[e] & 0xffffu); scr[(ch * 8 + 2 * e + 1) * 66 + c] = (bf16)(v[e] >> 16); } }
        __builtin_amdgcn_s_waitcnt(0xc07f); asm volatile("" ::: "memory");
#pragma unroll
        for (int i = 0; i < 8; ++i) { const int t = i * 8 + (lane >> 3), ch = lane & 7; const unsigned* sp = (const unsigned*)(scr + t * 66 + ch * 8);
            u32x4 o; o.x = sp[0]; o.y = sp[1]; o.z = sp[2]; o.w = sp[3]; *(u32x4*)(Z + (size_t)(t0 + t) * DM + c0 + ch * 8) = o; }
        __builtin_amdgcn_s_waitcnt(0xc07f); asm volatile("" ::: "memory");
    }
}

constexpr int DX_PITCH = 576, DF_PITCH = 272, DS_PITCH = 528;
constexpr int DX_OFF = 0, DF_OFF = 128 * DX_PITCH;
typedef short v4i16_t __attribute__((ext_vector_type(4)));
__device__ __forceinline__ v4i16_t lds_tr16(const unsigned char* p) { return __builtin_amdgcn_ds_read_tr16_b64_v4i16((__attribute__((address_space(3))) v4i16_t*)(uintptr_t)p); }
template <class RowPtr> __device__ __forceinline__ void dft_issue_x(u32x4 (&v)[8], int tid, const RowPtr& rp) {
    asm volatile("" : "+v"(tid));
#pragma unroll
    for (int i = 0; i < 8; ++i) { const int id = tid + 512 * i, row = id >> 5, c16 = id & 31; v[i] = *(const u32x4*)(rp(row) + 8 * c16); }
}
__device__ __forceinline__ void dft_commit_x(unsigned char* lds, const u32x4 (&v)[8], int tid) {
    asm volatile("" : "+v"(tid));
#pragma unroll
    for (int i = 0; i < 8; ++i) { const int id = tid + 512 * i, row = id >> 5, c16 = id & 31; *(u32x4*)(lds + DX_OFF + row * DX_PITCH + 16 * c16) = v[i]; }
}
template <int MB> __device__ __forceinline__ void dft_mma(f32x16 (&acc)[MB], const unsigned char* lds, int lane, int wave) {
    asm volatile("" : "+v"(lane));
    const int r = lane & 31, h = lane >> 5, g = lane >> 4, q = (lane >> 2) & 3, p = lane & 3;
    const unsigned char* ap = lds + DX_OFF + (8 * h + q) * DX_PITCH + (wave * 32 + 16 * (g & 1) + 4 * p) * 2;
    const unsigned char* bp = lds + DF_OFF + r * DF_PITCH + 16 * h;
#pragma unroll
    for (int ks = 0; ks < 8; ++ks) {
        const v4i16_t lo = lds_tr16(ap + ks * 16 * DX_PITCH), hi4 = lds_tr16(ap + ks * 16 * DX_PITCH + 4 * DX_PITCH);
        const bf16x8 A = (bf16x8){lo[0], lo[1], lo[2], lo[3], hi4[0], hi4[1], hi4[2], hi4[3]};
#pragma unroll
        for (int mb = 0; mb < MB; ++mb) { const bf16x8 B = *(const bf16x8*)(bp + mb * 32 * DF_PITCH + 32 * ks); acc[mb] = __builtin_amdgcn_mfma_f32_32x32x16_bf16(A, B, acc[mb], 0, 0, 0); }
        if (ks & 1) asm volatile("" ::: "memory");
    }
}
template <int MB> __device__ __forceinline__ void dft_stage(const f32x16 (&acc)[MB], unsigned char* lds, int lane, int wave, float scale) {
    asm volatile("" : "+v"(lane));
    const int r = lane & 31, h = lane >> 5;
#pragma unroll
    for (int mb = 0; mb < MB; ++mb)
#pragma unroll
        for (int g4 = 0; g4 < 4; ++g4) { u32x2 w; w.x = pk2(acc[mb][4 * g4] * scale, acc[mb][4 * g4 + 1] * scale); w.y = pk2(acc[mb][4 * g4 + 2] * scale, acc[mb][4 * g4 + 3] * scale);
            *(u32x2*)(lds + DX_OFF + (mb * 32 + r) * DS_PITCH + (wave * 32 + 8 * g4 + 4 * h) * 2) = w; }
}
template <int MB, bool GATE, class OutPtr, class GatePtr> __device__ __forceinline__ void dft_write(const unsigned char* lds, int tid, const OutPtr& op, const GatePtr& gp) {
    asm volatile("" : "+v"(tid));
#pragma unroll
    for (int i = 0; i < MB * 2; ++i) { const int id = tid + 512 * i, m = id >> 5, c16 = id & 31; u32x4 v = *(const u32x4*)(lds + DX_OFF + m * DS_PITCH + 16 * c16);
        if (GATE) { const u32x4 gv = *(const u32x4*)(gp(m) + 8 * c16);
#pragma unroll
            for (int e = 0; e < 4; ++e) v[e] = pk2(bf2f(v[e] & 0xffffu) * bf2f(gv[e] & 0xffffu), bf2f(v[e] >> 16) * bf2f(gv[e] >> 16)); }
        *(u32x4*)(op(m) + 8 * c16) = v; }
}
struct NoGate { __device__ __forceinline__ const bf16* operator()(int) const { return nullptr; } };

__device__ __forceinline__ void dft_stage1_phase(ArgsP a, unsigned char* lds, int tid, int lane, int wave, int bid, int G) {
    const bf16* A = (const bf16*)(a->ws + WS_A); const bf16* B = (const bf16*)(a->ws + WS_B); bf16* TR = (bf16*)(a->ws + WS_TR); bf16* TI = (bf16*)(a->ws + WS_TI);
    const float* TW = (const float*)(a->ws + WS_TW);
#pragma unroll 1
    for (int unit = bid; unit < 256; unit += G) { const int b = unit >> 6, n2 = unit & 63;
        u32x4 xv[8];
        auto rp1 = [&](int chunk) { return [=](int row) { const int part = row >> 6, n1 = row & 63; return (part ? B : A) + (size_t)(NPR + b * LSM + 64 * n1 + n2) * DM + chunk * 256; }; };
        dft_issue_x(xv, tid, rp1(0));
        __syncthreads();
        { float* tab = (float*)(lds + DX_OFF);
#pragma unroll
          for (int i = 0; i < 4; ++i) { const int id = tid + 512 * i; *(f32x4*)(tab + 4 * id) = *(const f32x4*)(TW + 4 * id); } }
        __syncthreads();
        { const float* tab = (const float*)(lds + DX_OFF);
          const int m = tid >> 2, po = m >> 6, k1 = m & 63, kq = tid & 3, pi = kq >> 1;
#pragma unroll
          for (int c8 = 0; c8 < 4; ++c8) { unsigned w[4];
#pragma unroll
              for (int e2 = 0; e2 < 4; ++e2) { float vv[2];
#pragma unroll
                  for (int t = 0; t < 2; ++t) { const int n1 = (kq & 1) * 32 + c8 * 8 + e2 * 2 + t; const int idx = (k1 * (64 * n1 + n2)) & 4095; const float cs = tab[2 * idx], sn = tab[2 * idx + 1];
                      vv[t] = po == 0 ? (pi == 0 ? cs : -sn) : (pi == 0 ? -sn : -cs); }
                  w[e2] = pk2(vv[0], vv[1]); }
              *(u32x4*)(lds + DF_OFF + m * DF_PITCH + (kq * 32 + c8 * 8) * 2) = (u32x4){w[0], w[1], w[2], w[3]}; } }
#pragma unroll 1
        for (int chunk = 0; chunk < 4; ++chunk) {
            __syncthreads();
            dft_commit_x(lds, xv, tid);
            if (chunk + 1 < 4) dft_issue_x(xv, tid, rp1(chunk + 1));
            __syncthreads();
            f32x16 acc[4] = {};
            dft_mma<4>(acc, lds, lane, wave);
            __syncthreads();
            dft_stage<4>(acc, lds, lane, wave, 1.0f);
            __syncthreads();
            dft_write<4, false>(lds, tid, [&](int m) { const int po = m >> 6, k1 = m & 63; return (po ? TI : TR) + ((size_t)((b * 64 + k1) * 64 + n2)) * DM + chunk * 256; }, NoGate());
        }
    }
    __syncthreads();
}
__device__ __forceinline__ void dft_stage2_phase(ArgsP a, unsigned char* lds, int tid, int lane, int wave, int first, int stride) {
    const bf16* TR = (const bf16*)(a->ws + WS_TR); const bf16* TI = (const bf16*)(a->ws + WS_TI); const bf16* SG = (const bf16*)(a->ws + WS_SG); bf16* Z2 = (bf16*)(a->ws + WS_Z2);
    const float* TW64 = (const float*)(a->ws + WS_TW) + 2 * (4096 + 256);
    __syncthreads();
    {
      const int m = tid >> 3, k0 = (tid & 7) * 16, pi = k0 >> 6;
#pragma unroll
      for (int c8 = 0; c8 < 2; ++c8) { unsigned w[4];
#pragma unroll
          for (int e2 = 0; e2 < 4; ++e2) { float vv[2];
#pragma unroll
              for (int t = 0; t < 2; ++t) { const int n2 = (k0 & 63) + c8 * 8 + e2 * 2 + t; const int idx = (m * n2) & 63; vv[t] = pi == 0 ? TW64[2 * idx] : TW64[2 * idx + 1]; }
              w[e2] = pk2(vv[0], vv[1]); }
          *(u32x4*)(lds + DF_OFF + m * DF_PITCH + (k0 + c8 * 8) * 2) = (u32x4){w[0], w[1], w[2], w[3]}; } }
#pragma unroll 1
    for (int hu = first; hu < 512; hu += stride) { const int unit = hu >> 1, cb0 = 2 * (hu & 1), b = unit >> 6, k1 = unit & 63;
        u32x4 xv[8];
        auto rp2 = [&](int chunk) { return [=](int row) { const int part = row >> 6, n2 = row & 63; return (part ? TI : TR) + ((size_t)((b * 64 + k1) * 64 + n2)) * DM + chunk * 256; }; };
        dft_issue_x(xv, tid, rp2(cb0));
#pragma unroll 1
        for (int chunk = cb0; chunk < cb0 + 2; ++chunk) {
            __syncthreads();
            dft_commit_x(lds, xv, tid);
            if (chunk + 1 < cb0 + 2) dft_issue_x(xv, tid, rp2(chunk + 1));
            __syncthreads();
            f32x16 acc[2] = {};
            dft_mma<2>(acc, lds, lane, wave);
            __syncthreads();
            dft_stage<2>(acc, lds, lane, wave, 0.015625f);
            __syncthreads();
            dft_write<2, true>(lds, tid, [&](int m) { return Z2 + (size_t)(NPR + b * LSM + k1 + 64 * m) * DM + chunk * 256; }, [&](int m) { return SG + (size_t)(NPR + b * LSM + k1 + 64 * m) * DM + chunk * 256; });
        }
    }
    __syncthreads();
}
constexpr int DTW_OFF = DF_OFF + 128 * DF_PITCH;
__device__ __forceinline__ void dft_prompt_phase(ArgsP a, unsigned char* lds, int tid, int lane, int wave, int bid, int G) {
    const bf16* A = (const bf16*)(a->ws + WS_A); const bf16* B = (const bf16*)(a->ws + WS_B); const bf16* SG = (const bf16*)(a->ws + WS_SG); bf16* Z2 = (bf16*)(a->ws + WS_Z2);
    __syncthreads();
    { const float* TW256 = (const float*)(a->ws + WS_TW) + 2 * 4096; ((float*)(lds + DTW_OFF))[tid] = TW256[tid]; }
    const float* tw = (const float*)(lds + DTW_OFF);
#pragma unroll 1
    for (int unit = bid; unit < 256; unit += G) { const int b = unit >> 4, q4 = (unit >> 2) & 3, chunk = unit & 3;
        f32x16 acc[2] = {};
        u32x4 xv[8];
        auto rpp = [&](int pc) { return [=](int row) { const int part = row >> 6, l = 64 * pc + (row & 63); return (part ? B : A) + (size_t)(b * LPR + l) * DM + chunk * 256; }; };
        dft_issue_x(xv, tid, rpp(0));
#pragma unroll 1
        for (int pc = 0; pc < 4; ++pc) {
            __syncthreads();
            {
              const int m = tid >> 3, lp = 64 * q4 + m, k0 = (tid & 7) * 16, pi = k0 >> 6;
#pragma unroll
              for (int c8 = 0; c8 < 2; ++c8) { unsigned w[4];
#pragma unroll
                  for (int e2 = 0; e2 < 4; ++e2) { float vv[2];
#pragma unroll
                      for (int t = 0; t < 2; ++t) { const int l = 64 * pc + (k0 & 63) + c8 * 8 + e2 * 2 + t; const int idx = (l * lp) & 255; vv[t] = pi == 0 ? tw[2 * idx] : -tw[2 * idx + 1]; }
                      w[e2] = pk2(vv[0], vv[1]); }
                  *(u32x4*)(lds + DF_OFF + m * DF_PITCH + (k0 + c8 * 8) * 2) = (u32x4){w[0], w[1], w[2], w[3]}; } }
            dft_commit_x(lds, xv, tid);
            if (pc + 1 < 4) dft_issue_x(xv, tid, rpp(pc + 1));
            __syncthreads();
            dft_mma<2>(acc, lds, lane, wave);
        }
        __syncthreads();
        dft_stage<2>(acc, lds, lane, wave, 0.0625f);
        __syncthreads();
        dft_write<2, true>(lds, tid, [&](int m) { return Z2 + (size_t)(b * LPR + 64 * q4 + m) * DM + chunk * 256; }, [&](int m) { return SG + (size_t)(b * LPR + 64 * q4 + m) * DM + chunk * 256; });
    }
    __syncthreads();
}

constexpr int NPHASE = 12;
#define PH_CTX const Ctx cx_ = get_ctx(); ArgsP A = cx_.a; const int G = A->grid, bid = cx_.bid; const int wave = cx_.wave, lane = LANE_ID(), tid = wave * 64 + lane; (void)tid; \
    unsigned char* const ws = A->ws; (void)G; (void)bid; (void)lane; (void)wave; (void)ws
__device__ __forceinline__ bool ph_in(int k) { const Ctx cx_ = get_ctx(); return cx_.a->ph_lo <= k && k < cx_.a->ph_hi; }
__device__ __forceinline__ void ph_seam(int k, unsigned char* lds) {
    const Ctx cx_ = get_ctx(); ArgsP A = cx_.a; const int wave_s = cx_.wave;
    if (A->ph_lo <= k && k + 1 <= A->ph_hi - 1) { XcdBarrier bar; bar.bar = (unsigned*)((gu32*)(A->ws + WS_CTL) + CW_BAR); bar.x = xb_xcc_id(); bar.st = (volatile LAS unsigned*)((LAS unsigned char*)lds + MISC_OFF) + 8; xcd_barrier(bar, wave_s == 0 && __builtin_amdgcn_mbcnt_hi(~0u, __builtin_amdgcn_mbcnt_lo(~0u, 0u)) == 0u); }
}
__global__ void __launch_bounds__(NWAVES * 64, 2) fwd_kernel(Args args_unused_directly) {
    unsigned char* const lds = g_lds;
    {
        const int wave0 = __builtin_amdgcn_readfirstlane((int)threadIdx.x >> 6), lane0 = LANE_ID(), tid0 = wave0 * 64 + lane0;
        LAS unsigned* cw = (LAS unsigned*)((LAS unsigned char*)lds + LDSCTL_OFF);
        for (int u = tid0; u < (LDS_BYTES - LDSCTL_OFF) / 4; u += NWAVES * 64) cw[u] = 0u;
        __syncthreads();
        const unsigned long long kp = (unsigned long long)(uintptr_t)__builtin_amdgcn_kernarg_segment_ptr();
        if (lane0 == 0) cw[hw_slot()] = (unsigned)wave0;
        if (tid0 == 0) cw[71] = 0u;
        if (tid0 == 0) { cw[64] = blockIdx.x; cw[66] = (unsigned)kp; cw[67] = (unsigned)(kp >> 32); }
        __syncthreads();
        ArgsP A = (ArgsP)__builtin_amdgcn_kernarg_segment_ptr();
        if (cw[hw_slot()] != (unsigned)wave0 && lane0 == 0) A->out[0] = __builtin_nanf("");
        if (A->ph_hi - A->ph_lo > 1) (void)xcd_barrier_post((unsigned*)((gu32*)(A->ws + WS_CTL) + CW_BAR), (volatile LAS unsigned*)((LAS unsigned char*)lds + MISC_OFF) + 8, tid0 == 0);
    }
#ifndef PH_MASK
#define PH_MASK 0xFFF
#endif
#define IN(k) ((((PH_MASK) >> (k)) & 1) && ph_in(k))
#ifndef REP_SEAM
#define REP_SEAM 1
#endif
#ifdef TSK
#define STAMP(i) do { const Ctx cs_ = get_ctx(); if (cs_.bid == 0 && cs_.wave == 0 && LANE_ID() == 0) { const unsigned long long t_ = __builtin_amdgcn_s_memrealtime(); \
    volatile LAS unsigned* w_ = (volatile LAS unsigned*)((LAS unsigned char*)g_lds + CTXW_OFF); w_[100 + 2 * (i)] = (unsigned)t_; w_[101 + 2 * (i)] = (unsigned)(t_ >> 32); \
    const unsigned long long c_ = __builtin_amdgcn_s_memtime(); w_[140 + 2 * (i)] = (unsigned)c_; w_[141 + 2 * (i)] = (unsigned)(c_ >> 32); } } while (0)
#else
#define STAMP(i) do { } while (0)
#endif
#define SEAM(k) do { for (int rs_ = 0; rs_ < REP_SEAM; ++rs_) ph_seam(k, lds); STAMP((k) + 1); } while (0)
#define BF(off) ((pg8::bf16_t*)(ws + (off)))
#define RING ((PG8_LAS unsigned char*)lds)

#ifndef REP_P0
#define REP_P0 1
#endif
    STAMP(0);
    if (IN(0)) { drain_segment(lds, 0); }
    SEAM(1);
#ifndef REP_P2
#define REP_P2 1
#endif
    if (IN(2)) for (int rep2 = 0; rep2 < REP_P2; ++rep2) {
        PH_CTX; pg8::Gemm g{BF(WS_WT_IN_E), BF(WS_H), 2048, NTOK, 1024, BF(WS_H), BF(WS_WT_IN_E) + (size_t)2048 * 1024};
        pg8::TwoOrder S; S.init(2048, NTOK, NTOK, 1024, G, bid);
        pg8::EpiP2 E{pg8::EpiP2a{ws}, pg8::EpiP2b{ws, A->out, A->in[I_QG], A->in[I_KVG]}};
        pg8::gemm_phase<pg8::EpiP2, pg8::TwoOrder, true, true>(RING, g, S, E, wave);
    }
#ifdef EXP_S1_AFTER
    SEAM(2);
    if (IN(2)) drain_segment(lds, 1);
    STAMP(20); ph_seam(2, lds);
#else
    if (IN(2)) drain_segment(lds, 1);
    SEAM(2);
#endif
    if (IN(3)) {
#ifndef NO_P3Q
        { PH_CTX; int K3 = 256; asm volatile("" : "+s"(K3));
          pg8::Gemm g{BF(WS_CQ), BF(WS_WT_UQ), NTOK, 768, K3}; pg8::StaticOrder S; S.init(NTOK, 768, G, bid);
          pg8::EpiP3q E{ws};
          pg8::gemm_phase<pg8::EpiP3q, pg8::StaticOrder, true, true>(RING, g, S, E, wave); }
#endif
#ifndef NO_P3K
        { PH_CTX; int K3 = 256; asm volatile("" : "+s"(K3));
          pg8::Gemm g{BF(WS_CKV), BF(WS_WT_UK), NKV, 512, K3}; pg8::StaticOrder S; S.init(NKV, 512, G, bid);
          pg8::EpiP3k E{ws};
          pg8::gemm_phase<pg8::EpiP3k, pg8::StaticOrder, true, true>(RING, g, S, E, wave); }
#endif
#ifndef NO_P3V
        { PH_CTX; int K3 = 256; asm volatile("" : "+s"(K3));
          pg8::Gemm g{BF(WS_WT_UV), BF(WS_CKV), 512, NKV, K3}; pg8::StaticOrder S; S.init(512, NKV, G, (bid + 176) % G);
          pg8::EpiP3v E{ws};
          pg8::gemm_phase<pg8::EpiP3v, pg8::StaticOrder, true, true>(RING, g, S, E, wave); }
#endif
        { PH_CTX; state_fix_phase(A, tid, bid, G);
#ifndef NO_HYENA
#ifndef REP_HYENA
#define REP_HYENA 1
#endif
          for (int rep = 0; rep < REP_HYENA; ++rep)
          for (int u = bid; u < 512; u += G) hyena_mfma_unit<true>(A, lds, u, tid, lane, wave);
          { const int pu = bid < 80 ? bid : (bid >= 176 ? bid - 96 : -1);
            if (pu >= 0 && pu < 128) hyena_mfma_unit<false>(A, lds, pu, tid, lane, wave); }
#endif
          __syncthreads(); }
    }
    if (IN(3)) drain_segment(lds, 2);
    SEAM(3);
    if (IN(4)) { PH_CTX; const int vcu = (G % 8 == 0) ? (bid % 8) * (G / 8) + bid / 8 : bid;
#ifndef NO_ATTN
#ifndef REP_ATTN
#define REP_ATTN 1
#endif
        for (int rep = 0; rep < REP_ATTN; ++rep) attn_phase(A, lds, tid, lane, wave, vcu, G);
#endif
#ifndef NO_TRANSP
#ifndef REP_TR
#define REP_TR 1
#endif
        for (int rep = 0; rep < REP_TR; ++rep) transpose_yt_phase(A, lds, lane, wave, bid, G);
#endif
        __syncthreads(); }
    if (IN(4)) drain_segment(lds, 3);
    SEAM(4);
#ifndef REP_P5
#define REP_P5 1
#endif
    if (IN(5)) { PH_CTX;
        if (G == 256) {
            { pg8::Gemm g{BF(WS_Z), BF(WS_WT_OUT_E), NTOK, 1024, 1024}; pg8::P5Order S; S.pc = (unsigned*)(ws + WS_CTL) + CW_PC5; S.c = bid;
              pg8::EpiResB<0> E{A->in[I_XP], A->in[I_XS], A->out, ws};
              pg8::gemm_phase<pg8::EpiResB<0>, pg8::P5Order, true, true>(RING, g, S, E, wave); }
            panel_queue<true>(lds, 5, 0, 256);
        } else {
            pg8::Gemm g{BF(WS_Z), BF(WS_WT_OUT_E), NTOK, 1024, 1024}; pg8::CountingOrder S; S.init(NTOK, 1024, G, bid); S.pc = (unsigned*)(ws + WS_CTL) + CW_PC5;
            pg8::EpiResB<0> E{A->in[I_XP], A->in[I_XS], A->out, ws};
            pg8::gemm_phase<pg8::EpiResB<0>, pg8::CountingOrder, true, true>(RING, g, S, E, wave);
        }
    }
    if (IN(5)) { PH_CTX;
        if (G == 256 && bid >= 64) {
            pg8::Gemm g{BF(WS_H), BF(WS_WT_IN_O), NPR, 3072, 1024}; pg8::P7GateOrder S; S.pr = (unsigned*)(ws + WS_CTL) + CW_PR; S.tmo = (unsigned*)(ws + WS_CTL) + CW_TMO; S.c = bid;
            pg8::EpiP7 E{ws};
            pg8::gemm_phase<pg8::EpiP7, pg8::P7GateOrder, true, true>(RING, g, S, E, wave);
        }
    }
    if (IN(5)) { PH_CTX; if (G == 256) panel_queue<true>(lds, 7, 256, 64); else panel_queue<true>(lds); }
    SEAM(5);
#ifndef REP_P7
#define REP_P7 1
#endif
    if (IN(7)) for (int rep7 = 0; rep7 < REP_P7; ++rep7) { PH_CTX;
        pg8::Gemm g{BF(WS_H), BF(WS_WT_IN_O), NTOK, 3072, 1024}; pg8::OffsetPlain S;
        if (G == 256) { S.init(NSM, 3072, G, bid); S.pm0 = NPR / 256; } else { S.init(NTOK, 3072, G, bid); S.pm0 = 0; }
        pg8::EpiP7 E{ws};
        pg8::gemm_phase<pg8::EpiP7, pg8::OffsetPlain, true, true>(RING, g, S, E, wave);
    }
    if (IN(7)) drain_segment(lds, 4);
    SEAM(7);
#ifndef REP_DFT
#define REP_DFT 1
#endif
    if (IN(8)) { PH_CTX; for (int rep = 0; rep < REP_DFT; ++rep) { dft_stage1_phase(A, lds, tid, lane, wave, bid, G); dft_prompt_phase(A, lds, tid, lane, wave, bid, G); } __syncthreads(); }
    SEAM(8);
    if (IN(9)) { PH_CTX;
        if (G == 256 && bid < 64) {
            pg8::Gemm g{BF(WS_Z2), BF(WS_WT_OUT_O), NPR, 1024, 1024}; pg8::CountingOrder S; S.init(NPR, 1024, 64, bid); S.pc = (unsigned*)(ws + WS_CTL) + CW_PC10;
            pg8::EpiResB<1> E{nullptr, nullptr, A->out, ws};
            pg8::gemm_phase<pg8::EpiResB<1>, pg8::CountingOrder, true, true>(RING, g, S, E, wave);
        } else if (G == 256) dft_stage2_phase(A, lds, tid, lane, wave, bid - 64, 192);
        else dft_stage2_phase(A, lds, tid, lane, wave, bid, G);
        __syncthreads(); }
    SEAM(9);
    if (IN(10)) { PH_CTX;
        pg8::Gemm g{BF(WS_Z2), BF(WS_WT_OUT_O), NTOK, 1024, 1024}; pg8::OffsetOrder S; S.pc = (unsigned*)(ws + WS_CTL) + CW_PC10;
        if (G == 256) { S.init(NSM, 1024, G, bid); S.pm0 = NPR / 256; } else { S.init(NTOK, 1024, G, bid); S.pm0 = 0; }
        pg8::EpiResB<1> E{nullptr, nullptr, A->out, ws};
        pg8::gemm_phase<pg8::EpiResB<1>, pg8::OffsetOrder, true, true>(RING, g, S, E, wave);
    }
    if (IN(10)) panel_queue<false>(lds);
#ifdef TSK
    STAMP(12);
    { PH_CTX; __syncthreads();
      if (bid == 0) { volatile LAS unsigned* w_ = (volatile LAS unsigned*)((LAS unsigned char*)g_lds + CTXW_OFF);
        const unsigned long long t0 = ((unsigned long long)w_[101 + 2 * (TSK)] << 32) | w_[100 + 2 * (TSK)], t1 = ((unsigned long long)w_[101 + 2 * (TSK2)] << 32) | w_[100 + 2 * (TSK2)];
        const unsigned long long c0 = ((unsigned long long)w_[141 + 2 * (TSK)] << 32) | w_[140 + 2 * (TSK)], c1 = ((unsigned long long)w_[141 + 2 * (TSK2)] << 32) | w_[140 + 2 * (TSK2)];
#ifdef TS_CLOCK
        const float us = (float)(c1 - c0) / (float)(t1 - t0) * 100.0f;
#else
        const float us = (float)(t1 - t0) * 0.01f;
#endif
        const float f = 1.0f + 1e-3f * us; float* sk = A->out + (size_t)NTOK * DM + (size_t)NPR * 256;
        for (int i = tid; i < NPR * 32; i += 512) sk[i] *= f; } }
#endif
#undef IN
#undef SEAM
#undef BF
#undef RING
}

extern "C" void kernel_launch(void* const* d_in, const int* in_sizes, int n_in, void* d_out, int out_size, void* d_ws, size_t ws_size, hipStream_t stream) {
    static int grid = 0;
    if (grid == 0) {
        if (n_in != 27 || out_size != NTOK * DM + NPR * 256 + NPR * 32 || ws_size < WS_END) { fprintf(stderr, "kernel_launch: unexpected shapes (n_in %d out %d ws %zu)\n", n_in, out_size, ws_size); grid = -1; return; }
        int dev = 0, cus = 0, per_cu = 0;
        if (hipGetDevice(&dev) != hipSuccess || hipDeviceGetAttribute(&cus, hipDeviceAttributeMultiprocessorCount, dev) != hipSuccess) { grid = -1; return; }
        if (hipFuncSetAttribute((const void*)fwd_kernel, hipFuncAttributeMaxDynamicSharedMemorySize, LDS_BYTES) != hipSuccess) { fprintf(stderr, "kernel_launch: hipFuncSetAttribute failed\n"); grid = -1; return; }
        if (hipOccupancyMaxActiveBlocksPerMultiprocessor(&per_cu, (const void*)fwd_kernel, NWAVES * 64, LDS_BYTES) != hipSuccess || per_cu < 1) { fprintf(stderr, "kernel_launch: occupancy query says %d blocks per CU\n", per_cu); per_cu = 1; }
        (void)hipGetLastError();
        grid = cus;
    }
    if (grid < 0) return;
    (void)hipMemsetAsync((char*)d_ws + WS_CTL, 0, CTL_ZERO_BYTES, stream);
    Args a{};
    for (int i = 0; i < 27; ++i) a.in[i] = (const float*)d_in[i];
    a.out = (float*)d_out; a.ws = (unsigned char*)d_ws; a.grid = grid; a.pad = 0;
#if MK_N_LAUNCHES == 1
    a.ph_lo = 0; a.ph_hi = NPHASE;
    hipLaunchKernelGGL(fwd_kernel, dim3(grid), dim3(NWAVES * 64), LDS_BYTES, stream, a);
#else
    for (int p = 0; p < NPHASE; ++p) { a.ph_lo = p; a.ph_hi = p + 1; hipLaunchKernelGGL(fwd_kernel, dim3(grid), dim3(NWAVES * 64), LDS_BYTES, stream, a); }
#endif
}
```
